# Optimizing an MI355X kernel written in HIP

```python
import math
import jax
import jax.numpy as jnp
from jax import lax
import numpy as np

D_MODEL = 1024
BATCH = 8
SEQ = 2048
DEPTH = 1

N_META = 16
D_MIX = 2 * D_MODEL
SSD_WIDTH = D_MIX // 2
SSD_HEAD_DIM = 64
SSD_HEADS = SSD_WIDTH // SSD_HEAD_DIM
SSD_GROUPS = 2
SSD_HPG = SSD_HEADS // SSD_GROUPS
SSD_STATE = 128
SSD_CONV = 4
SSD_CHUNK = 128
SSD_CONV_DIM = SSD_WIDTH + 2 * SSD_GROUPS * SSD_STATE
LRU_WIDTH = D_MIX - SSD_WIDTH
LRU_BLOCKS = 16
LRU_BLOCK_W = LRU_WIDTH // LRU_BLOCKS
LRU_CONV = 4
LRU_C = 8.0
D_FF = -(-(8 * D_MODEL) // (3 * 256)) * 256
IN_COLS = SSD_WIDTH + SSD_CONV_DIM + SSD_HEADS + 2 * LRU_WIDTH
IN_SPLITS = [SSD_WIDTH, SSD_WIDTH + SSD_CONV_DIM, SSD_WIDTH + SSD_CONV_DIM + SSD_HEADS, SSD_WIDTH + SSD_CONV_DIM + SSD_HEADS + LRU_WIDTH]
EPS = 1e-6

kernel_name = 'hymba_ssd_rglru_hybrid_block'


def rmsnorm(x, w):
    xf = x.astype(jnp.float32)
    y = xf * lax.rsqrt(jnp.mean(xf * xf, axis=-1, keepdims=True) + EPS)
    return (y * w.astype(jnp.float32)).astype(x.dtype)


def causal_dwconv(x, w, b):
    k, c = w.shape
    y = lax.conv_general_dilated(x, w[:, None, :].astype(x.dtype), window_strides=(1,), padding=[(k - 1, 0)], dimension_numbers=('NWC', 'WIO', 'NWC'), feature_group_count=c)
    return y + b.astype(x.dtype)


def _to_chunks(t, pad):
    t = jnp.pad(t, [(0, 0), (pad, 0)] + [(0, 0)] * (t.ndim - 2))
    return t.reshape((t.shape[0], -1, SSD_CHUNK) + t.shape[2:])


def ssd_mixer(z, xbc, dt_raw, conv_w, conv_b, dt_bias, a_log, d_skip, norm_w):
    bsz, seqlen, _ = z.shape
    f32 = jnp.float32
    xbc = jax.nn.silu(causal_dwconv(xbc, conv_w, conv_b))
    xs, b_in, c_in = jnp.split(xbc, [SSD_WIDTH, SSD_WIDTH + SSD_GROUPS * SSD_STATE], axis=-1)
    dt = jax.nn.softplus(dt_raw.astype(f32) + dt_bias.astype(f32))
    a = -jnp.exp(a_log.astype(f32)).reshape(SSD_GROUPS, SSD_HPG)
    pad = (-seqlen) % SSD_CHUNK
    x_c = _to_chunks(xs.astype(f32).reshape(bsz, seqlen, SSD_GROUPS, SSD_HPG, SSD_HEAD_DIM), pad)
    b_c = _to_chunks(b_in.astype(f32).reshape(bsz, seqlen, SSD_GROUPS, SSD_STATE), pad)
    c_c = _to_chunks(c_in.astype(f32).reshape(bsz, seqlen, SSD_GROUPS, SSD_STATE), pad)
    dt_c = _to_chunks(dt.reshape(bsz, seqlen, SSD_GROUPS, SSD_HPG), pad)
    cs = jnp.cumsum(dt_c * a, axis=2)
    xdt = x_c * dt_c[..., None]
    causal = jnp.tril(jnp.ones((SSD_CHUNK, SSD_CHUNK), dtype=bool))
    seg = cs[:, :, :, None] - cs[:, :, None, :]
    lmat = jnp.exp(jnp.where(causal[:, :, None, None], seg, -jnp.inf))
    cb = jnp.einsum('bclgn,bcsgn->bclsg', c_c, b_c)
    y_diag = jnp.einsum('bclsgj,bcsgjp->bclgjp', cb[..., None] * lmat, xdt)
    decay_states = jnp.exp(cs[:, :, -1:] - cs)
    states = jnp.einsum('bclgn,bclgjp->bcgjpn', b_c, xdt * decay_states[..., None])
    chunk_decay = jnp.exp(cs[:, :, -1])

    def step(h, inp):
        s, d = inp
        return h * d[..., None, None] + s, h

    h0 = jnp.zeros((bsz, SSD_GROUPS, SSD_HPG, SSD_HEAD_DIM, SSD_STATE), f32)
    _, prev = lax.scan(step, h0, (jnp.moveaxis(states, 1, 0), jnp.moveaxis(chunk_decay, 1, 0)))
    prev = jnp.moveaxis(prev, 0, 1)
    y_off = jnp.einsum('bclgn,bcgjpn->bclgjp', c_c, prev) * jnp.exp(cs)[..., None]
    y = (y_diag + y_off).reshape(bsz, -1, SSD_WIDTH)[:, pad:]
    y = y + (xs.astype(f32).reshape(bsz, seqlen, SSD_HEADS, SSD_HEAD_DIM) * d_skip.astype(f32)[:, None]).reshape(bsz, seqlen, SSD_WIDTH)
    y = y.astype(z.dtype)
    g = (y * jax.nn.silu(z)).reshape(bsz, seqlen, SSD_GROUPS, SSD_WIDTH // SSD_GROUPS)
    return rmsnorm(g, norm_w.reshape(SSD_GROUPS, -1)).reshape(bsz, seqlen, SSD_WIDTH)


def rglru_mixer(gate, xr, conv_w, conv_b, wa, ba, wx, bx, lam, norm_w):
    bsz, seqlen, _ = xr.shape
    f32 = jnp.float32
    xr = causal_dwconv(xr, conv_w, conv_b)
    xb = xr.reshape(bsz, seqlen, LRU_BLOCKS, LRU_BLOCK_W)
    r = jax.nn.sigmoid(jnp.einsum('btni,nij->btnj', xb, wa).reshape(bsz, seqlen, LRU_WIDTH) + ba)
    i = jax.nn.sigmoid(jnp.einsum('btni,nij->btnj', xb, wx).reshape(bsz, seqlen, LRU_WIDTH) + bx)
    log_a = -LRU_C * r.astype(f32) * jax.nn.softplus(-lam.astype(f32))
    a = jnp.exp(log_a)
    u = jnp.sqrt(-jnp.expm1(2.0 * log_a)) * (i * xr).astype(f32)

    def combine(left, right):
        a1, b1 = left
        a2, b2 = right
        return a1 * a2, a2 * b1 + b2

    _, h = lax.associative_scan(combine, (a, u), axis=1)
    y = jax.nn.gelu(gate) * h.astype(gate.dtype)
    return rmsnorm(y, norm_w)


def setup_inputs(seed: int = 0) -> dict:
    key = jax.random.key(seed)
    ks = jax.random.split(key, 24)
    nrm = jax.random.normal
    dt0 = jnp.exp(jax.random.uniform(ks[6], (DEPTH, SSD_HEADS), minval=math.log(1e-3), maxval=math.log(1e-1)))
    a_base = jax.random.uniform(ks[15], (DEPTH, LRU_WIDTH), minval=0.9, maxval=0.999)
    s = a_base ** (1.0 / LRU_C)
    return {
        'x': nrm(ks[0], (BATCH, SEQ, D_MODEL), jnp.float32),
        'meta_tokens': nrm(ks[1], (N_META, D_MODEL), jnp.float32),
        'norm1_w': 1.0 + 0.02 * nrm(ks[2], (DEPTH, D_MODEL)),
        'w_in': nrm(ks[3], (DEPTH, D_MODEL, IN_COLS)) * D_MODEL ** -0.5,
        'ssd_conv_w': nrm(ks[4], (DEPTH, SSD_CONV, SSD_CONV_DIM)) * SSD_CONV ** -0.5,
        'ssd_conv_b': 0.02 * nrm(ks[5], (DEPTH, SSD_CONV_DIM)),
        'ssd_dt_bias': dt0 + jnp.log(-jnp.expm1(-dt0)),
        'ssd_a_log': jnp.log(jax.random.uniform(ks[7], (DEPTH, SSD_HEADS), minval=1.0, maxval=16.0)),
        'ssd_d': 1.0 + 0.1 * nrm(ks[8], (DEPTH, SSD_HEADS)),
        'ssd_norm_w': 1.0 + 0.02 * nrm(ks[9], (DEPTH, SSD_WIDTH)),
        'lru_conv_w': nrm(ks[10], (DEPTH, LRU_CONV, LRU_WIDTH)) * LRU_CONV ** -0.5,
        'lru_conv_b': 0.02 * nrm(ks[11], (DEPTH, LRU_WIDTH)),
        'lru_wa': nrm(ks[12], (DEPTH, LRU_BLOCKS, LRU_BLOCK_W, LRU_BLOCK_W)) * LRU_BLOCK_W ** -0.5,
        'lru_ba': 0.02 * nrm(ks[13], (DEPTH, LRU_WIDTH)),
        'lru_wx': nrm(ks[14], (DEPTH, LRU_BLOCKS, LRU_BLOCK_W, LRU_BLOCK_W)) * LRU_BLOCK_W ** -0.5,
        'lru_bx': 0.02 * nrm(ks[16], (DEPTH, LRU_WIDTH)),
        'lru_lambda': jnp.log(s) - jnp.log1p(-s),
        'lru_norm_w': 1.0 + 0.02 * nrm(ks[17], (DEPTH, LRU_WIDTH)),
        'w_out': nrm(ks[18], (DEPTH, D_MIX, D_MODEL)) * D_MIX ** -0.5,
        'norm2_w': 1.0 + 0.02 * nrm(ks[19], (DEPTH, D_MODEL)),
        'w_gate': nrm(ks[20], (DEPTH, D_MODEL, D_FF)) * D_MODEL ** -0.5,
        'w_up': nrm(ks[21], (DEPTH, D_MODEL, D_FF)) * D_MODEL ** -0.5,
        'w_down': nrm(ks[22], (DEPTH, D_FF, D_MODEL)) * D_FF ** -0.5,
        'final_norm_w': 1.0 + 0.02 * nrm(ks[23], (D_MODEL,)),
    }


def reference(x, meta_tokens, norm1_w, w_in, ssd_conv_w, ssd_conv_b, ssd_dt_bias, ssd_a_log, ssd_d, ssd_norm_w, lru_conv_w, lru_conv_b, lru_wa, lru_ba, lru_wx, lru_bx, lru_lambda, lru_norm_w, w_out, norm2_w, w_gate, w_up, w_down, final_norm_w):
    bsz = x.shape[0]
    meta = jnp.broadcast_to(meta_tokens.astype(x.dtype)[None], (bsz, N_META, D_MODEL))
    h = jnp.concatenate([meta, x], axis=1)
    for li in range(DEPTH):
        u = rmsnorm(h, norm1_w[li])
        proj = u @ w_in[li]
        z, xbc, dt_raw, g_lru, x_lru = jnp.split(proj, IN_SPLITS, axis=-1)
        y_ssd = ssd_mixer(z, xbc, dt_raw, ssd_conv_w[li], ssd_conv_b[li], ssd_dt_bias[li], ssd_a_log[li], ssd_d[li], ssd_norm_w[li])
        y_lru = rglru_mixer(g_lru, x_lru, lru_conv_w[li], lru_conv_b[li], lru_wa[li], lru_ba[li], lru_wx[li], lru_bx[li], lru_lambda[li], lru_norm_w[li])
        h = h + jnp.concatenate([y_ssd, y_lru], axis=-1) @ w_out[li]
        u = rmsnorm(h, norm2_w[li])
        h = h + (jax.nn.silu(u @ w_gate[li]) * (u @ w_up[li])) @ w_down[li]
    h = rmsnorm(h, final_norm_w)
    return h[:, N_META:]
```

```cpp
#ifndef WGM_P1
#define WGM_P1 2
#define WGM_P4 2
#endif
#include <hip/hip_runtime.h>
#include <hip/hip_cooperative_groups.h>
#include <cstdio>
#include <cstdint>
namespace cg = cooperative_groups;

#ifndef MK_LAUNCHES
#define MK_LAUNCHES 1
#endif

constexpr int D = 1024, BATCH = 8, SEQ = 2048, NMETA = 16;
constexpr int MROWS = BATCH * SEQ;
constexpr int M1 = MROWS + 256;
constexpr int NPROJ = 4608;
constexpr int N1 = 4864;
constexpr int IN_COLS = 4624;
constexpr int DMIX = 2048, DFF = 2816, NGU = 2 * DFF;
constexpr int COL_Z = 0, COL_XBC = 1024, COL_GATE = 2560, COL_XLRU = 3584;
constexpr float EPS = 1e-6f;
constexpr size_t MiB = 1u << 20;
constexpr size_t WS_WIN = 0, WS_WOUT = 10 * MiB, WS_WGU = 14 * MiB, WS_WD = 25 * MiB;
constexpr size_t WS_RSTD1 = 31 * MiB, WS_DTRAW = 31 * MiB + 128 * 1024, WS_SSQS = 33 * MiB, WS_SSQL = 34 * MiB, WS_SSQ2 = 35 * MiB, WS_SSQ3 = 35 * MiB + 512 * 1024;
constexpr size_t WS_MIX = 36 * MiB, WS_PROJ = 100 * MiB, WS_ACT = WS_PROJ, WS_H1B = WS_PROJ + 96 * MiB;
constexpr size_t WS_END = WS_PROJ + (size_t)M1 * NPROJ * 2;
static_assert(WS_END <= 256 * MiB, "workspace map");
constexpr int LDS_BYTES = 147456;
constexpr int NTHREADS = 512;

namespace pg8 {
#define PG8_LAS __attribute__((address_space(3)))
typedef unsigned short bf16_t;
typedef short bf16x8 __attribute__((ext_vector_type(8)));
typedef float f32x4 __attribute__((ext_vector_type(4)));
typedef unsigned u32x4 __attribute__((ext_vector_type(4)));
constexpr int BM = 256, BK = 64, HALF = 128, HTB = HALF * BK * 2  , STAGE_BYTES = 8 * HTB, NXCD = 8, WGM = 4;

__host__ __device__ __forceinline__ int lds_byte(int r, int c) { const int st = (r >> 4) * 2 + (c >> 5), rr = r & 15, cc = c & 31, ob = rr * 64 + cc * 2; return st * 1024 + (ob ^ (((ob >> 9) & 1) << 5)); }
__host__ __device__ __forceinline__ void stage_rc(int b, int& R, int& C) { const int st = b / 1024, sb = b % 1024, swz = sb ^ (((sb >> 9) & 1) << 5); R = (st >> 1) * 16 + swz / 64; C = (st & 1) * 32 + (swz % 64) / 2; }
__host__ __device__ __forceinline__ int perm32(int rho) { const int n = rho >> 4, i = rho & 15; return 8 * (i >> 2) + 4 * n + (i & 3); }

struct Unit { int pm, pn; };
struct Gemm { const bf16_t* A; const bf16_t* Bt; int M, N, K; };

struct StaticOrder {
    int nM, nN, nwg, G, c, wgm;
    __host__ __device__ void init(int M, int N, int G_, int c_, int wgm_ = WGM) { nM = M / BM; nN = N / BM; nwg = nM * nN; G = G_; c = c_; wgm = wgm_; }
    __host__ __device__ bool next(int i, Unit& u) const {
        const long L = (long)i * G + c; if (L >= nwg) return false;
        int wgid = (int)L; { const int q = nwg / NXCD, r = nwg % NXCD, xcd = wgid % NXCD, off = wgid / NXCD; wgid = (xcd < r ? xcd * (q + 1) : r * (q + 1) + (xcd - r) * q) + off; }
        const int nig = wgm * nN, gid = wgid / nig, fm = gid * wgm, gsz = (nM - fm) < wgm ? (nM - fm) : wgm;
        u.pm = fm + ((wgid % nig) % gsz); u.pn = (wgid % nig) / gsz; return true;
    }
    __device__ __forceinline__ void a_ready(const Unit&) const {}
    __device__ __forceinline__ void done(const Unit&) const {}
};

__device__ __forceinline__ unsigned cvt_pk_bf16(float lo, float hi) { unsigned r; asm volatile("v_cvt_pk_bf16_f32 %0, %1, %2" : "=v"(r) : "v"(lo), "v"(hi)); return r; }
typedef unsigned u32x2 __attribute__((ext_vector_type(2)));
__device__ __forceinline__ float sigmoidf_(float x) { return __builtin_amdgcn_rcpf(1.0f + __expf(-x)); }

struct EpiProj {
    static constexpr bool PERM = true, AFTER_DRAIN = false, KHOOK = false; static constexpr int KH0 = -1, KH1 = -1;
    bf16_t* proj; float* dtraw; const float* rstd1;
    __device__ __forceinline__ void operator()(const f32x4 (&acc)[2][2][4][2], const Unit& u, int wr, int wc, int fr, int fq) const {
        const int row0 = u.pm * BM + wr * 64 + fr;
        if (u.pn == 18) {
            if (wc == 0 && fq < 2) {
#pragma unroll
                for (int ai = 0; ai < 2; ++ai)
#pragma unroll
                    for (int m = 0; m < 4; ++m) { const int row = row0 + ai * HALF + m * 16; const float s = rstd1[row]; float* dp = dtraw + (size_t)row * 16 + 8 * fq;
                        *(f32x4*)dp = acc[ai][0][m][0] * s; *(f32x4*)(dp + 4) = acc[ai][0][m][1] * s; } }
            return;
        }
        const bool isz = u.pn < 4, isg = (u.pn >= 10 && u.pn < 14);
        bf16_t* base = proj + (size_t)row0 * NPROJ + u.pn * BM + wc * 32 + 8 * fq;
        if (isz || isg) {
            const float c1 = isz ? 1.0f : 1.5957691216057308f, c3 = isz ? 0.f : 0.07135481627f;
#pragma unroll
            for (int ai = 0; ai < 2; ++ai)
#pragma unroll
                for (int m = 0; m < 4; ++m) { const float s = rstd1[row0 + ai * HALF + m * 16]; bf16_t* rowp = base + (size_t)(ai * HALF + m * 16) * NPROJ;
#pragma unroll
                    for (int bj = 0; bj < 2; ++bj) { f32x4 v0 = acc[ai][bj][m][0] * s, v1 = acc[ai][bj][m][1] * s;
#pragma unroll
                        for (int j = 0; j < 4; ++j) { v0[j] = v0[j] * sigmoidf_(v0[j] * (c1 + c3 * v0[j] * v0[j])); v1[j] = v1[j] * sigmoidf_(v1[j] * (c1 + c3 * v1[j] * v1[j])); }
                        u32x4 w; w.x = cvt_pk_bf16(v0[0], v0[1]); w.y = cvt_pk_bf16(v0[2], v0[3]); w.z = cvt_pk_bf16(v1[0], v1[1]); w.w = cvt_pk_bf16(v1[2], v1[3]);
                        __builtin_nontemporal_store(w, (u32x4*)(rowp + bj * HALF)); } }
        } else {
#pragma unroll
            for (int ai = 0; ai < 2; ++ai)
#pragma unroll
                for (int m = 0; m < 4; ++m) { const float s = rstd1[row0 + ai * HALF + m * 16]; bf16_t* rowp = base + (size_t)(ai * HALF + m * 16) * NPROJ;
#pragma unroll
                    for (int bj = 0; bj < 2; ++bj) { const f32x4 v0 = acc[ai][bj][m][0] * s, v1 = acc[ai][bj][m][1] * s;
                        u32x4 w; w.x = cvt_pk_bf16(v0[0], v0[1]); w.y = cvt_pk_bf16(v0[2], v0[3]); w.z = cvt_pk_bf16(v1[0], v1[1]); w.w = cvt_pk_bf16(v1[2], v1[3]);
                        __builtin_nontemporal_store(w, (u32x4*)(rowp + bj * HALF)); } }
        }
    }
    __device__ __forceinline__ void khook(f32x4 (&)[2][2][4][2], int, int, int, PG8_LAS unsigned char*) const {}
};
struct EpiOut {
    static constexpr bool PERM = false, AFTER_DRAIN = true, KHOOK = true; static constexpr int KH0 = 8, KH1 = 16;
    bf16_t* h1b; float* ssq2;
    __device__ __forceinline__ void khook(f32x4 (&acc)[2][2][4][2], int t, int wr, int fr, PG8_LAS unsigned char* lds) const {
        const PG8_LAS f32x4* T = (const PG8_LAS f32x4*)(lds + STAGE_BYTES);
#pragma unroll
        for (int ai = 0; ai < 2; ++ai)
#pragma unroll
            for (int m = 0; m < 4; ++m) { const f32x4 tv = T[ai * HALF + wr * 64 + m * 16 + fr]; const float s = (t == KH0) ? tv.x : tv.y;
#pragma unroll
                for (int bj = 0; bj < 2; ++bj)
#pragma unroll
                    for (int n = 0; n < 2; ++n) acc[ai][bj][m][n] *= s; }
    }
    __device__ __forceinline__ void operator()(const f32x4 (&)[2][2][4][2], const Unit&, int, int, int, int) const {}
    __device__ __forceinline__ void fused(f32x4 (&acc)[2][2][4][2], const Unit& u, int wr, int wc, int fr, int fq, PG8_LAS unsigned char* lds, int wid, int lane) const {
        const PG8_LAS f32x4* T = (const PG8_LAS f32x4*)(lds + STAGE_BYTES);
        PG8_LAS float* Pp = (PG8_LAS float*)lds;
        const int col0 = u.pn * BM + wc * 32 + 4 * fq;
#pragma unroll
        for (int ai = 0; ai < 2; ++ai) {
#pragma unroll
            for (int m = 0; m < 4; ++m) { const int r = ai * HALF + wr * 64 + m * 16 + fr; const float s = T[r].z; const size_t off = (size_t)(u.pm * BM + r) * D + col0; float ss = 0.f;
#pragma unroll
                for (int bj = 0; bj < 2; ++bj)
#pragma unroll
                    for (int n = 0; n < 2; ++n) { const size_t o = off + bj * HALF + n * 16; const f32x4 hv = acc[ai][bj][m][n] * s;
                        ss += (hv[0] * hv[0] + hv[1] * hv[1]) + (hv[2] * hv[2] + hv[3] * hv[3]);
                        u32x2 w; w.x = cvt_pk_bf16(hv[0], hv[1]); w.y = cvt_pk_bf16(hv[2], hv[3]); *(u32x2*)(h1b + o) = w; }
                ss += __shfl_xor(ss, 16); ss += __shfl_xor(ss, 32);
                if (fq == 0) Pp[r * 4 + wc] = ss; }
        }
        asm volatile("s_waitcnt lgkmcnt(0)" ::: "memory"); __builtin_amdgcn_s_barrier(); asm volatile("" ::: "memory");
        const int tid = wid * 64 + lane;
        if (tid < 256) { const f32x4 p = *(const PG8_LAS f32x4*)(Pp + tid * 4); ssq2[(size_t)(u.pm * BM + tid) * 4 + u.pn] = (p[0] + p[1]) + (p[2] + p[3]); }
    }
};
struct EpiGU {
    static constexpr bool PERM = true, AFTER_DRAIN = false, KHOOK = false; static constexpr int KH0 = -1, KH1 = -1;
    bf16_t* act; const float* ssq2;
    __device__ __forceinline__ void operator()(const f32x4 (&acc)[2][2][4][2], const Unit& u, int wr, int wc, int fr, int fq) const {
        const int row0 = u.pm * BM + wr * 64 + fr;
#pragma unroll
        for (int ai = 0; ai < 2; ++ai)
#pragma unroll
            for (int m = 0; m < 4; ++m) { const int row = row0 + ai * HALF + m * 16; const f32x4 q = *(const f32x4*)(ssq2 + (size_t)row * 4);
                const float s = __frsqrt_rn(((q[0] + q[1]) + (q[2] + q[3])) * (1.0f / D) + EPS);
                float o[8];
#pragma unroll
                for (int n = 0; n < 2; ++n)
#pragma unroll
                    for (int j = 0; j < 4; ++j) { const float g = acc[ai][0][m][n][j] * s, up = acc[ai][1][m][n][j] * s; o[n * 4 + j] = g * sigmoidf_(g) * up; }
                u32x4 w; w.x = cvt_pk_bf16(o[0], o[1]); w.y = cvt_pk_bf16(o[2], o[3]); w.z = cvt_pk_bf16(o[4], o[5]); w.w = cvt_pk_bf16(o[6], o[7]);
                __builtin_nontemporal_store(w, (u32x4*)(act + (size_t)row * DFF + u.pn * HALF + wc * 32 + 8 * fq)); }
    }
    __device__ __forceinline__ void khook(f32x4 (&)[2][2][4][2], int, int, int, PG8_LAS unsigned char*) const {}
};
struct EpiDown {
    static constexpr bool PERM = false, AFTER_DRAIN = true, KHOOK = false; static constexpr int KH0 = -1, KH1 = -1;
    float* hout; float* ssq3;
    __device__ __forceinline__ void khook(f32x4 (&)[2][2][4][2], int, int, int, PG8_LAS unsigned char*) const {}
    __device__ __forceinline__ void operator()(const f32x4 (&)[2][2][4][2], const Unit&, int, int, int, int) const {}
    __device__ __forceinline__ void fused(f32x4 (&acc)[2][2][4][2], const Unit& u, int wr, int wc, int fr, int fq, PG8_LAS unsigned char* lds, int wid, int lane) const {
        PG8_LAS float* Pp = (PG8_LAS float*)lds;
        const int col0 = u.pn * BM + wc * 32 + 4 * fq;
#pragma unroll
        for (int ai = 0; ai < 2; ++ai)
#pragma unroll
            for (int m = 0; m < 4; ++m) { const int r = ai * HALF + wr * 64 + m * 16 + fr; const size_t off = (size_t)(u.pm * BM + r) * D + col0; float ss = 0.f;
#pragma unroll
                for (int bj = 0; bj < 2; ++bj)
#pragma unroll
                    for (int n = 0; n < 2; ++n) { const size_t o = off + bj * HALF + n * 16; const f32x4 hv = *(const f32x4*)(hout + o) + acc[ai][bj][m][n];
                        *(f32x4*)(hout + o) = hv; ss += (hv[0] * hv[0] + hv[1] * hv[1]) + (hv[2] * hv[2] + hv[3] * hv[3]); }
                ss += __shfl_xor(ss, 16); ss += __shfl_xor(ss, 32);
                if (fq == 0) Pp[r * 4 + wc] = ss; }
        asm volatile("s_waitcnt lgkmcnt(0)" ::: "memory"); __builtin_amdgcn_s_barrier(); asm volatile("" ::: "memory");
        const int tid = wid * 64 + lane;
        if (tid < 256) { const f32x4 p = *(const PG8_LAS f32x4*)(Pp + tid * 4); ssq3[(size_t)(u.pm * BM + tid) * 4 + u.pn] = (p[0] + p[1]) + (p[2] + p[3]); }
    }
};

struct EpiDownNorm {
    static constexpr bool PERM = false, AFTER_DRAIN = true, KHOOK = false; static constexpr int KH0 = -1, KH1 = -1;
    float* hout; const float* fw; float* xbuf; unsigned* cnt;
    __device__ __forceinline__ void khook(f32x4 (&)[2][2][4][2], int, int, int, PG8_LAS unsigned char*) const {}
    __device__ __forceinline__ void operator()(const f32x4 (&)[2][2][4][2], const Unit&, int, int, int, int) const {}
    __device__ __forceinline__ void fused(f32x4 (&acc)[2][2][4][2], const Unit& u, int wr, int wc, int fr, int fq, PG8_LAS unsigned char* lds, int wid, int lane) const {
        PG8_LAS float* Pp = (PG8_LAS float*)lds; PG8_LAS float* Sr = (PG8_LAS float*)(lds + 8192);
        const int col0 = u.pn * BM + wc * 32 + 4 * fq;
#pragma unroll
        for (int ai = 0; ai < 2; ++ai) {
#pragma unroll
            for (int m = 0; m < 4; ++m) { const int r = ai * HALF + wr * 64 + m * 16 + fr; float ss = 0.f;
#pragma unroll
                for (int bj = 0; bj < 2; ++bj)
#pragma unroll
                    for (int n = 0; n < 2; ++n) { const f32x4 hv = acc[ai][bj][m][n];
                        ss += (hv[0] * hv[0] + hv[1] * hv[1]) + (hv[2] * hv[2] + hv[3] * hv[3]); }
                ss += __shfl_xor(ss, 16); ss += __shfl_xor(ss, 32);
                if (fq == 0) Pp[r * 4 + wc] = ss; }
        }
        asm volatile("s_waitcnt lgkmcnt(0)" ::: "memory"); __builtin_amdgcn_s_barrier(); asm volatile("" ::: "memory");
        const int tid = wid * 64 + lane;
        if (tid < 256) { const f32x4 p = *(const PG8_LAS f32x4*)(Pp + tid * 4);
            __hip_atomic_store(xbuf + (size_t)(u.pm * BM + tid) * 4 + u.pn, (p[0] + p[1]) + (p[2] + p[3]), __ATOMIC_RELAXED, __HIP_MEMORY_SCOPE_AGENT);
            asm volatile("s_waitcnt vmcnt(0)" ::: "memory");
            if (lane == 0) __hip_atomic_fetch_add(cnt + 64 * u.pm, 1u, __ATOMIC_RELAXED, __HIP_MEMORY_SCOPE_AGENT); }
        if (wid == 0) { unsigned spins = 0;
            while ((unsigned)__builtin_amdgcn_readfirstlane((int)__hip_atomic_load(cnt + 64 * u.pm, __ATOMIC_RELAXED, __HIP_MEMORY_SCOPE_AGENT)) < 16u) { __builtin_amdgcn_s_sleep(2); if (++spins > (1u << 22)) break; }
            __builtin_amdgcn_fence(__ATOMIC_ACQUIRE, "agent"); }
        asm volatile("s_waitcnt vmcnt(0) lgkmcnt(0)" ::: "memory"); __builtin_amdgcn_s_barrier(); asm volatile("" ::: "memory");
        if (tid < 256) { const float* slot = xbuf + (size_t)(u.pm * BM + tid) * 4; float q = 0.f;
#pragma unroll
            for (int t = 0; t < 4; ++t) q += __hip_atomic_load(slot + t, __ATOMIC_RELAXED, __HIP_MEMORY_SCOPE_AGENT);
            Sr[tid] = __frsqrt_rn(q * (1.0f / D) + EPS); }
        asm volatile("s_waitcnt lgkmcnt(0)" ::: "memory"); __builtin_amdgcn_s_barrier(); asm volatile("" ::: "memory");
        f32x4 wv[2][2];
#pragma unroll
        for (int bj = 0; bj < 2; ++bj)
#pragma unroll
            for (int n = 0; n < 2; ++n) wv[bj][n] = *(const f32x4*)(fw + col0 + bj * HALF + n * 16);
#pragma unroll
        for (int ai = 0; ai < 2; ++ai)
#pragma unroll
            for (int m = 0; m < 4; ++m) { const int r = ai * HALF + wr * 64 + m * 16 + fr; const size_t off = (size_t)(u.pm * BM + r) * D + col0; const float s = Sr[r];
#pragma unroll
                for (int bj = 0; bj < 2; ++bj)
#pragma unroll
                    for (int n = 0; n < 2; ++n) *(f32x4*)(hout + off + bj * HALF + n * 16) = acc[ai][bj][m][n] * s * wv[bj][n]; }
    }
};

template <class Epi, class Sched, bool ALIGN_EPI = false, bool SP2 = false, bool INIT = false>
__device__ __forceinline__ void gemm_phase(PG8_LAS unsigned char* lds, const Gemm g, const Sched& S, const Epi& E, f32x4 (&acc)[2][2][4][2]) {
    const int tid = threadIdx.x, wid = __builtin_amdgcn_readfirstlane(tid >> 6), lane = tid & 63, wr = wid >> 2, wc = wid & 3, fr = lane & 15, fq = lane >> 4;
    const int K = g.K, nt = K / BK;
    unsigned voffA[2], voffB[2];
#pragma unroll
    for (int i = 0; i < 2; ++i) { int R, C; stage_rc(tid * 16 + i * 8192, R, C); const int Rb = Epi::PERM ? ((R & ~31) + perm32(R & 31)) : R;
        voffA[i] = (unsigned)(R * K + C) * 2u; voffB[i] = (unsigned)(Rb * K + C) * 2u; }
    const size_t kstep = (size_t)(BK * 2);
    const size_t hstep = (size_t)HALF * K * 2;
    const size_t tstep = 2 * hstep;
    const unsigned ldsw = (unsigned)wid * 1024u;
    const int aoff = lds_byte(wr * 64 + fr, fq * 8), boff = lds_byte(wc * 32 + fr, fq * 8);
#define PG8_SA(b, h) (((b) * 2 + (h)) * HTB)
#define PG8_SB(b, h) ((4 + (b) * 2 + (h)) * HTB)
#define PG8_STAGE(bufoff, gbase, voff) do { _Pragma("unroll") for (int _i = 0; _i < 2; ++_i) \
        __builtin_amdgcn_global_load_lds((const unsigned*)((const char*)(gbase) + (voff)[_i]), (PG8_LAS unsigned*)(lds + (bufoff) + ldsw + _i * 8192), 16, 0, 0); } while (0)
#define PG8_LDA(dst, b, h) do { _Pragma("unroll") for (int m = 0; m < 4; ++m) _Pragma("unroll") for (int k = 0; k < 2; ++k) dst[m][k] = *(const PG8_LAS bf16x8*)(lds + PG8_SA(b, h) + aoff + m * 2048 + k * 1024); } while (0)
#define PG8_LDB(dst, b, h) do { _Pragma("unroll") for (int n = 0; n < 2; ++n) _Pragma("unroll") for (int k = 0; k < 2; ++k) dst[n][k] = *(const PG8_LAS bf16x8*)(lds + PG8_SB(b, h) + boff + n * 2048 + k * 1024); } while (0)
#define PG8_MMA(ai, bj, At, Bt) do { __builtin_amdgcn_s_setprio(1); _Pragma("unroll") for (int m = 0; m < 4; ++m) _Pragma("unroll") for (int n = 0; n < 2; ++n) _Pragma("unroll") for (int k = 0; k < 2; ++k) \
        acc[ai][bj][m][n] = __builtin_amdgcn_mfma_f32_16x16x32_bf16(Bt[n][k], At[m][k], acc[ai][bj][m][n], 0, 0, 0); __builtin_amdgcn_s_setprio(0); } while (0)
#define PG8_WAIT_V(n) asm volatile("s_waitcnt vmcnt(" #n ")" ::: "memory")
#define PG8_WAIT_L(n) asm volatile("s_waitcnt lgkmcnt(" #n ")" ::: "memory")
#define PG8_BAR __builtin_amdgcn_s_barrier()
#define PG8_SCHED __builtin_amdgcn_sched_barrier(0)
    Unit cur, nxt; int ui = 0;
    if (!S.next(0, cur)) return;
#pragma unroll
    for (int a = 0; a < 2; ++a)
#pragma unroll
        for (int b = 0; b < 2; ++b)
#pragma unroll
            for (int m = 0; m < 4; ++m)
#pragma unroll
                for (int n = 0; n < 2; ++n) { if constexpr (!INIT) acc[a][b][m][n] = (f32x4){0.f, 0.f, 0.f, 0.f}; }
    bf16x8 At[4][2], B0[2][2], B1[2][2];
    const char* cA = (const char*)g.A + (size_t)cur.pm * tstep; const char* cB = (const char*)g.Bt + (size_t)cur.pn * tstep;
    S.a_ready(cur);
    if constexpr (SP2) {
        PG8_STAGE(PG8_SB(0, 0), cB, voffB); PG8_STAGE(PG8_SB(0, 1), cB + hstep, voffB); PG8_STAGE(PG8_SA(0, 0), cA, voffA); PG8_STAGE(PG8_SA(0, 1), cA + hstep, voffA);
        if (wr == 1) PG8_BAR;
        PG8_WAIT_V(2); PG8_BAR;
        PG8_STAGE(PG8_SB(1, 0), cB + kstep, voffB); PG8_STAGE(PG8_SA(1, 0), cA + kstep, voffA); PG8_STAGE(PG8_SB(1, 1), cB + hstep + kstep, voffB);
        PG8_WAIT_V(6); PG8_BAR;
    } else {
        PG8_STAGE(PG8_SB(0, 0), cB, voffB); PG8_STAGE(PG8_SA(0, 0), cA, voffA); PG8_STAGE(PG8_SB(0, 1), cB + hstep, voffB); PG8_STAGE(PG8_SA(0, 1), cA + hstep, voffA);
        if (wr == 1) PG8_BAR;
        PG8_WAIT_V(4); PG8_BAR;
        PG8_STAGE(PG8_SB(1, 0), cB + kstep, voffB); PG8_STAGE(PG8_SA(1, 0), cA + kstep, voffA); PG8_STAGE(PG8_SB(1, 1), cB + hstep + kstep, voffB);
        PG8_WAIT_V(6); PG8_BAR;
    }
    for (;;) {
        const bool has_next = S.next(ui + 1, nxt);
        const char* nA = has_next ? (const char*)g.A + (size_t)nxt.pm * tstep : cA; const char* nB = has_next ? (const char*)g.Bt + (size_t)nxt.pn * tstep : cB;
        for (int t = 0; t < nt; t += 2) {
            const bool last = (t == nt - 2);
            const char* a1 = cA + (size_t)(t + 1) * kstep;
            const char* a2 = last ? nA : cA + (size_t)(t + 2) * kstep; const char* b2 = last ? nB : cB + (size_t)(t + 2) * kstep;
            const char* a3 = a2 + kstep; const char* b3 = b2 + kstep;
            if (last && has_next) S.a_ready(nxt);
            if constexpr (Epi::KHOOK) { if (t == Epi::KH0 || t == Epi::KH1) E.khook(acc, t, wr, fr, lds); }
            if constexpr (SP2) {
            PG8_LDB(B0, 0, 0); PG8_LDB(B1, 0, 1); PG8_SCHED; PG8_LDA(At, 0, 0); PG8_STAGE(PG8_SA(1, 1), a1 + hstep, voffA);
            PG8_WAIT_V(8); PG8_WAIT_L(0); PG8_BAR; PG8_MMA(0, 0, At, B0); PG8_MMA(0, 1, At, B1); PG8_BAR; PG8_SCHED;
            PG8_LDA(At, 0, 1); PG8_STAGE(PG8_SB(0, 0), b2, voffB); PG8_STAGE(PG8_SB(0, 1), b2 + hstep, voffB); PG8_STAGE(PG8_SA(0, 0), a2, voffA);
            PG8_WAIT_V(8); PG8_WAIT_L(0); PG8_BAR; PG8_MMA(1, 0, At, B0); PG8_MMA(1, 1, At, B1); PG8_BAR; PG8_SCHED;
            PG8_LDB(B0, 1, 0); PG8_LDB(B1, 1, 1); PG8_SCHED; PG8_LDA(At, 1, 0); PG8_STAGE(PG8_SA(0, 1), a2 + hstep, voffA);
            PG8_WAIT_V(8); PG8_WAIT_L(0); PG8_BAR; PG8_MMA(0, 0, At, B0); PG8_MMA(0, 1, At, B1); PG8_BAR; PG8_SCHED;
            PG8_LDA(At, 1, 1); PG8_STAGE(PG8_SB(1, 0), b3, voffB); PG8_STAGE(PG8_SB(1, 1), b3 + hstep, voffB); PG8_STAGE(PG8_SA(1, 0), a3, voffA);
            PG8_WAIT_V(8); PG8_WAIT_L(0); PG8_BAR; PG8_MMA(1, 0, At, B0); PG8_MMA(1, 1, At, B1); PG8_BAR; PG8_SCHED;
            } else {
            PG8_LDB(B0, 0, 0); PG8_SCHED; PG8_LDA(At, 0, 0); PG8_STAGE(PG8_SA(1, 1), a1 + hstep, voffA);
            PG8_WAIT_L(8); PG8_BAR; PG8_WAIT_L(0); PG8_MMA(0, 0, At, B0); PG8_BAR; PG8_SCHED;
            PG8_LDB(B1, 0, 1); PG8_STAGE(PG8_SB(0, 0), b2, voffB);
            PG8_BAR; PG8_WAIT_L(0); PG8_MMA(0, 1, At, B1); PG8_BAR;
            PG8_LDA(At, 0, 1); PG8_STAGE(PG8_SA(0, 0), a2, voffA);
            PG8_BAR; PG8_WAIT_L(0); PG8_MMA(1, 0, At, B0); PG8_BAR; PG8_SCHED;
            PG8_STAGE(PG8_SB(0, 1), b2 + hstep, voffB);
            PG8_WAIT_V(6); PG8_BAR; PG8_MMA(1, 1, At, B1); PG8_BAR;
            PG8_LDB(B0, 1, 0); PG8_SCHED; PG8_LDA(At, 1, 0); PG8_STAGE(PG8_SA(0, 1), a2 + hstep, voffA);
            PG8_WAIT_L(8); PG8_BAR; PG8_WAIT_L(0); PG8_MMA(0, 0, At, B0); PG8_BAR; PG8_SCHED;
            PG8_LDB(B1, 1, 1); PG8_STAGE(PG8_SB(1, 0), b3, voffB);
            PG8_BAR; PG8_WAIT_L(0); PG8_MMA(0, 1, At, B1); PG8_BAR;
            PG8_LDA(At, 1, 1); PG8_STAGE(PG8_SA(1, 0), a3, voffA);
            PG8_BAR; PG8_WAIT_L(0); PG8_MMA(1, 0, At, B0); PG8_BAR; PG8_SCHED;
            PG8_STAGE(PG8_SB(1, 1), b3 + hstep, voffB);
            PG8_WAIT_V(6); PG8_BAR; PG8_MMA(1, 1, At, B1); PG8_BAR;
            }
        }
        if constexpr (ALIGN_EPI) { if (wr == 0) PG8_BAR; }
        if constexpr (!Epi::AFTER_DRAIN) { E(acc, cur, wr, wc, fr, fq); S.done(cur); }
        if (!has_next) break;
#pragma unroll
        for (int a = 0; a < 2; ++a)
#pragma unroll
            for (int b = 0; b < 2; ++b)
#pragma unroll
                for (int m = 0; m < 4; ++m)
#pragma unroll
                    for (int n = 0; n < 2; ++n) acc[a][b][m][n] = (f32x4){0.f, 0.f, 0.f, 0.f};
        cur = nxt; cA = nA; cB = nB; ++ui;
        if constexpr (ALIGN_EPI) { if (wr == 1) PG8_BAR; }
    }
    PG8_WAIT_V(0);
    if constexpr (!ALIGN_EPI) { if (wr == 0) PG8_BAR; }
    PG8_BAR;
    if constexpr (Epi::AFTER_DRAIN) { E.fused(acc, cur, wr, wc, fr, fq, lds, wid, lane); S.done(cur); }
#undef PG8_SA
#undef PG8_SB
#undef PG8_STAGE
#undef PG8_LDA
#undef PG8_LDB
#undef PG8_MMA
#undef PG8_WAIT_V
#undef PG8_WAIT_L
#undef PG8_BAR
#undef PG8_SCHED
}
}
typedef unsigned short bf16_t;
typedef short bf16x8 __attribute__((ext_vector_type(8)));
typedef float f32x4 __attribute__((ext_vector_type(4)));
typedef unsigned u32x4 __attribute__((ext_vector_type(4)));
typedef unsigned u32x2 __attribute__((ext_vector_type(2)));
#define LAS __attribute__((address_space(3)))
#define LDS_WAIT() asm volatile("s_waitcnt lgkmcnt(0)" ::: "memory")

struct Params {
    const float *x, *meta, *norm1_w, *w_in, *ssd_conv_w, *ssd_conv_b, *ssd_dt_bias, *ssd_a_log, *ssd_d, *ssd_norm_w;
    const float *lru_conv_w, *lru_conv_b, *lru_wa, *lru_ba, *lru_wx, *lru_bx, *lru_lambda, *lru_norm_w;
    const float *w_out, *norm2_w, *w_gate, *w_up, *w_down, *final_norm_w;
    float* out; unsigned char* ws;
    int ph_lo, ph_hi;
};

__device__ __forceinline__ float bf2f(unsigned short b) { return __uint_as_float(((unsigned)b) << 16); }
__device__ __forceinline__ float bflo(unsigned w) { return __uint_as_float(w << 16); }
__device__ __forceinline__ float bfhi(unsigned w) { return __uint_as_float(w & 0xffff0000u); }
typedef float f32x2_t __attribute__((ext_vector_type(2))); typedef __bf16 bf16x2_t __attribute__((ext_vector_type(2)));
__device__ __forceinline__ unsigned pk2(float lo, float hi) { f32x2_t v = {lo, hi}; bf16x2_t b = __builtin_convertvector(v, bf16x2_t); return __builtin_bit_cast(unsigned, b); }
__device__ __forceinline__ unsigned short f2bf(float f) { return (unsigned short)(pk2(f, 0.f) & 0xffffu); }
__device__ __forceinline__ float sigm(float x) { return __builtin_amdgcn_rcpf(1.0f + __expf(-x)); }
__device__ __forceinline__ float siluf(float x) { return x * sigm(x); }
__device__ __forceinline__ float softplusf(float x) { return x > 20.f ? x : log1pf(__expf(x)); }
__device__ __forceinline__ float dpp_add(float v, const int ctrl_sel) {
    switch (ctrl_sel) {
        case 0: return v + __builtin_bit_cast(float, __builtin_amdgcn_update_dpp(0, __builtin_bit_cast(int, v), 0xB1, 0xF, 0xF, true));
        case 1: return v + __builtin_bit_cast(float, __builtin_amdgcn_update_dpp(0, __builtin_bit_cast(int, v), 0x4E, 0xF, 0xF, true));
        case 2: return v + __builtin_bit_cast(float, __builtin_amdgcn_update_dpp(0, __builtin_bit_cast(int, v), 0x141, 0xF, 0xF, true));
        default: return v + __builtin_bit_cast(float, __builtin_amdgcn_update_dpp(0, __builtin_bit_cast(int, v), 0x140, 0xF, 0xF, true));
    }
}
__device__ __forceinline__ float row16_sum(float v) { v = dpp_add(v, 0); v = dpp_add(v, 1); v = dpp_add(v, 2); v = dpp_add(v, 3); return v; }
__device__ __forceinline__ float wave_sum(float v) {
    v = row16_sum(v);
    const int iv = __builtin_bit_cast(int, v);
    return (__builtin_bit_cast(float, __builtin_amdgcn_readlane(iv, 0)) + __builtin_bit_cast(float, __builtin_amdgcn_readlane(iv, 16))) + (__builtin_bit_cast(float, __builtin_amdgcn_readlane(iv, 32)) + __builtin_bit_cast(float, __builtin_amdgcn_readlane(iv, 48)));
}
__device__ __forceinline__ int tok_row(int b, int t) { return t < NMETA ? MROWS + t : b * SEQ + (t - NMETA); }

template <bool SC> __device__ __forceinline__ void tr_item(const float* colp, bool valid, int Nsrc, const float* sck0, bf16_t* WT, int K, int n0, int k0, LAS float* scr, int lane) {
    const int hi = lane >> 5; float v[32];
#pragma unroll
    for (int i = 0; i < 32; ++i) v[i] = __builtin_nontemporal_load(colp + (size_t)(k0 + 2 * i + hi) * Nsrc);
    if (SC) {
#pragma unroll
        for (int i = 0; i < 32; ++i) v[i] *= sck0[2 * i + hi]; }
#pragma unroll
    for (int i = 0; i < 32; ++i) scr[(2 * i + hi) * 33 + (lane & 31)] = valid ? v[i] : 0.f;
    LDS_WAIT(); asm volatile("" ::: "memory");
    const int c = lane & 7;
#pragma unroll
    for (int j = 0; j < 4; ++j) { const int n = (lane >> 3) + 8 * j; const LAS float* s = scr + (8 * c) * 33 + n;
        u32x4 o; o.x = pk2(s[0 * 33], s[1 * 33]); o.y = pk2(s[2 * 33], s[3 * 33]); o.z = pk2(s[4 * 33], s[5 * 33]); o.w = pk2(s[6 * 33], s[7 * 33]);
        *(u32x4*)(WT + (size_t)(n0 + n) * K + k0 + 8 * c) = o; }
    LDS_WAIT(); asm volatile("" ::: "memory");
}
__device__ __forceinline__ void weight_items(const Params& P, unsigned char* lds, int part) {
    const int tid = threadIdx.x, lane = tid & 63, wave = tid >> 6;
    LAS float* scr = (LAS float*)((LAS unsigned char*)lds + wave * 16384);
    const int gw = blockIdx.x * 8 + wave, NGW = gridDim.x * 8;
    bf16_t* WinT = (bf16_t*)(P.ws + WS_WIN); bf16_t* WoutT = (bf16_t*)(P.ws + WS_WOUT); bf16_t* WguT = (bf16_t*)(P.ws + WS_WGU); bf16_t* WdT = (bf16_t*)(P.ws + WS_WD);
    constexpr int I_IN = 16 * (N1 / 32), I_OUT = 32 * 32, I_GU = 16 * (NGU / 32), I_D = (DFF / 64) * 32;
    const int ln = lane & 31;
    if (part == 0) {
        for (int r = gw; r < I_IN; r += NGW) { const int nnb = N1 / 32, kb = r / nnb, nb = r % nnb, n = 32 * nb + ln;
            int sc = -1; if (n < 2560) sc = n; else if (n < NPROJ) sc = n + 16; else if (n < NPROJ + 16) sc = 2560 + (n - NPROJ);
            tr_item<true>(P.w_in + (sc < 0 ? 0 : sc), sc >= 0, IN_COLS, P.norm1_w + 64 * kb, WinT, D, 32 * nb, 64 * kb, scr, lane); }
        return;
    }
    for (int it = gw; it < I_OUT + I_GU + I_D; it += NGW) {
        int r = it;
        if (r < I_OUT) { const int kb = r / 32, nb = r % 32, k0 = 64 * kb;
            tr_item<true>(P.w_out + 32 * nb + ln, true, D, k0 < 1024 ? P.ssd_norm_w + k0 : P.lru_norm_w + (k0 - 1024), WoutT, DMIX, 32 * nb, k0, scr, lane); continue; }
        r -= I_OUT;
        if (r < I_GU) { const int nnb = NGU / 32, kb = r / nnb, nb = r % nnb, n = 32 * nb + ln; const int pn = n >> 8, bj = (n >> 7) & 1, jj = n & 127;
            tr_item<true>((bj ? P.w_up : P.w_gate) + 128 * pn + jj, true, DFF, P.norm2_w + 64 * kb, WguT, D, 32 * nb, 64 * kb, scr, lane); continue; }
        r -= I_GU;
        { const int kb = r / 32, nb = r % 32; tr_item<false>(P.w_down + 32 * nb + ln, true, D, nullptr, WdT, DFF, 32 * nb, 64 * kb, scr, lane); }
    }
}
__device__ __forceinline__ void p0_prologue(const Params& P, unsigned char* lds) {
    const int tid = threadIdx.x, lane = tid & 63, wave = tid >> 6;
    const int gw = blockIdx.x * 8 + wave, NGW = gridDim.x * 8;
    weight_items(P, lds, 0);
    bf16_t* Xb = (bf16_t*)P.out; float* rstd1 = (float*)(P.ws + WS_RSTD1);
    for (int base = gw; base < M1; base += 3 * NGW) {
        f32x4 v[3][4];
#pragma unroll
        for (int u = 0; u < 3; ++u) { const int row = base + u * NGW;
            const int mr = row - MROWS; const float* src = row < MROWS ? P.x + (size_t)row * D : P.meta + (size_t)(mr < NMETA ? mr : NMETA - 1) * D; const bool zr = row >= MROWS + NMETA;
#pragma unroll
            for (int j = 0; j < 4; ++j) { const f32x4 ld = __builtin_nontemporal_load((const f32x4*)src + lane + 64 * j); v[u][j] = zr ? (f32x4){0.f, 0.f, 0.f, 0.f} : ld; } }
#pragma unroll
        for (int u = 0; u < 3; ++u) { const int row = base + u * NGW; if (row < M1) { float s = 0.f;
#pragma unroll
            for (int j = 0; j < 4; ++j) s += (v[u][j][0] * v[u][j][0] + v[u][j][1] * v[u][j][1]) + (v[u][j][2] * v[u][j][2] + v[u][j][3] * v[u][j][3]);
            s = wave_sum(s);
            if (lane == 0) rstd1[row] = __frsqrt_rn(s * (1.0f / D) + EPS);
            u32x2* o8 = (u32x2*)(Xb + (size_t)row * D) + lane;
#pragma unroll
            for (int j = 0; j < 4; ++j) { u32x2 w; w.x = pk2(v[u][j][0], v[u][j][1]); w.y = pk2(v[u][j][2], v[u][j][3]); o8[64 * j] = w; } } }
    }
}

constexpr int PITCH = 272;
#define MFMA16(a, b, c) __builtin_amdgcn_mfma_f32_16x16x32_bf16((a), (b), (c), 0, 0, 0)
constexpr size_t IMG_G = 98304, IMG_XS_BASE = (size_t)BATCH * 17 * 2 * IMG_G, IMG_SC_BASE = IMG_XS_BASE + (size_t)BATCH * 17 * 16 * 16384, IMG_END = IMG_SC_BASE + (size_t)BATCH * 17 * 16 * 1536;
static_assert(IMG_END <= (size_t)MROWS * D * 4, "SSD images fit in d_out");
constexpr size_t WS_SUMA = 247 * MiB, WS_SUMH = 248 * MiB, WS_BAR = 249 * MiB;

#define CVT8(dst, src) do { dst[0] = bflo(src.x); dst[1] = bfhi(src.x); dst[2] = bflo(src.y); dst[3] = bfhi(src.y); dst[4] = bflo(src.z); dst[5] = bfhi(src.z); dst[6] = bflo(src.w); dst[7] = bfhi(src.w); } while (0)

__device__ __forceinline__ void ssd_prep_item(const Params& P, unsigned char* ldsg, int b, int c, int kind) {
    LAS unsigned char* T = (LAS unsigned char*)ldsg;
    const int tid = threadIdx.x, lane = tid & 63, w = __builtin_amdgcn_readfirstlane(tid >> 6);
    const int t0 = c == 0 ? -112 : NMETA + 128 * (c - 1);
    unsigned char* IMG = (unsigned char*)P.out;
    const bf16_t* proj = (const bf16_t*)(P.ws + WS_PROJ);
    const int bc = b * 17 + c;
    if (kind < 4) {
        const int g = kind & 1, isC = kind >> 1, oct = tid & 15, l0 = 4 * (tid >> 4);
        const int cch = 1024 + isC * 256 + g * 128 + oct * 8;
        u32x4 rw[7];
#pragma unroll
        for (int i = 0; i < 7; ++i) { const int t = t0 + l0 - 3 + i; const u32x4 ld = *(const u32x4*)(proj + (size_t)tok_row(b, t < 0 ? 0 : t) * NPROJ + COL_XBC + cch); rw[i] = t >= 0 ? ld : (u32x4){0u, 0u, 0u, 0u}; }
        float cw[4][8], cb[8];
#pragma unroll
        for (int k = 0; k < 4; ++k) { const f32x4 a0 = *(const f32x4*)(P.ssd_conv_w + k * 1536 + cch), a1 = *(const f32x4*)(P.ssd_conv_w + k * 1536 + cch + 4);
#pragma unroll
            for (int j = 0; j < 4; ++j) { cw[k][j] = a0[j]; cw[k][4 + j] = a1[j]; } }
        { const f32x4 b0 = *(const f32x4*)(P.ssd_conv_b + cch), b1 = *(const f32x4*)(P.ssd_conv_b + cch + 4);
#pragma unroll
          for (int j = 0; j < 4; ++j) { cb[j] = b0[j]; cb[4 + j] = b1[j]; } }
        float y[4][8];
#pragma unroll
        for (int k = 0; k < 4; ++k)
#pragma unroll
            for (int j = 0; j < 8; ++j) y[k][j] = cb[j];
#pragma unroll
        for (int i = 0; i < 7; ++i) { float xv[8]; CVT8(xv, rw[i]);
#pragma unroll
            for (int k = 0; k < 4; ++k) { const int tap = i - k; if (tap >= 0 && tap < 4) {
#pragma unroll
                for (int j = 0; j < 8; ++j) y[k][j] += cw[tap][j] * xv[j]; } } }
        unsigned char* img = IMG + ((size_t)bc * 2 + g) * IMG_G + (isC ? 65536 : 0);
#pragma unroll
        for (int k = 0; k < 4; ++k) { const bool valid = (t0 + l0 + k) >= 0;
#pragma unroll
            for (int j = 0; j < 8; ++j) y[k][j] = valid ? siluf(y[k][j]) : 0.f;
            u32x4 o; o.x = pk2(y[k][0], y[k][1]); o.y = pk2(y[k][2], y[k][3]); o.z = pk2(y[k][4], y[k][5]); o.w = pk2(y[k][6], y[k][7]);
            *(u32x4*)(img + ((l0 + k) * 128 + oct * 8) * 2) = o; }
        if (!isC) {
#pragma unroll
            for (int j = 0; j < 8; ++j) { u32x2 o; o.x = pk2(y[0][j], y[1][j]); o.y = pk2(y[2][j], y[3][j]); *(LAS u32x2*)(T + (oct * 8 + j) * PITCH + l0 * 2) = o; }
            __syncthreads();
#pragma unroll
            for (int k = 0; k < 4; ++k) { const int piece = tid + 512 * k, n = piece >> 4, k16 = piece & 15; const u32x4 v = *(const LAS u32x4*)(T + n * PITCH + k16 * 16);
                *(u32x4*)(img + 32768 + n * 256 + k16 * 16) = v; }
            __syncthreads();
        }
    } else {
        const int g = (kind - 4) >> 1, hh = (kind - 4) & 1, h0 = 8 * g + 4 * hh;
        if (w < 4) {
            const int h = h0 + w; const float Aneg = -__expf(P.ssd_a_log[h]), dtb = P.ssd_dt_bias[h]; const float* dtraw = (const float*)(P.ws + WS_DTRAW);
            float d0 = 0.f, d1 = 0.f; const int ta = t0 + 2 * lane, tb = ta + 1;
            { const float r0 = dtraw[(size_t)tok_row(b, ta < 0 ? 0 : ta) * 16 + h], r1 = dtraw[(size_t)tok_row(b, tb < 0 ? 0 : tb) * 16 + h];
              d0 = ta >= 0 ? softplusf(r0 + dtb) : 0.f; d1 = tb >= 0 ? softplusf(r1 + dtb) : 0.f; }
            const float v0 = d0 * Aneg, v1 = d1 * Aneg, s = v0 + v1; float inc = s;
#pragma unroll
            for (int o = 1; o < 64; o <<= 1) { const float nb = __shfl_up(inc, o); if (lane >= o) inc += nb; }
            const float exc = inc - s, cs0 = exc + v0, cs1 = inc, csEnd = __shfl(inc, 63);
            float* sc = (float*)(IMG + IMG_SC_BASE + ((size_t)bc * 16 + h) * 1536);
            typedef float f32x2 __attribute__((ext_vector_type(2)));
            *(f32x2*)(sc + 2 * lane) = (f32x2){d0, d1}; *(f32x2*)(sc + 128 + 2 * lane) = (f32x2){cs0, cs1}; *(f32x2*)(sc + 256 + 2 * lane) = (f32x2){d0 * __expf(csEnd - cs0), d1 * __expf(csEnd - cs1)};
        }
        const int oct = tid & 31, l0 = 8 * (tid >> 5), cch = h0 * 64 + oct * 8;
        u32x4 rw[11];
#pragma unroll
        for (int i = 0; i < 11; ++i) { const int t = t0 + l0 - 3 + i; const u32x4 ld = *(const u32x4*)(proj + (size_t)tok_row(b, t < 0 ? 0 : t) * NPROJ + COL_XBC + cch); rw[i] = t >= 0 ? ld : (u32x4){0u, 0u, 0u, 0u}; }
        float cw[4][8], cb[8];
#pragma unroll
        for (int k = 0; k < 4; ++k) { const f32x4 a0 = *(const f32x4*)(P.ssd_conv_w + k * 1536 + cch), a1 = *(const f32x4*)(P.ssd_conv_w + k * 1536 + cch + 4);
#pragma unroll
            for (int j = 0; j < 4; ++j) { cw[k][j] = a0[j]; cw[k][4 + j] = a1[j]; } }
        { const f32x4 b0 = *(const f32x4*)(P.ssd_conv_b + cch), b1 = *(const f32x4*)(P.ssd_conv_b + cch + 4);
#pragma unroll
          for (int j = 0; j < 4; ++j) { cb[j] = b0[j]; cb[4 + j] = b1[j]; } }
#pragma unroll
        for (int hf = 0; hf < 2; ++hf) {
            float y[4][8];
#pragma unroll
            for (int k = 0; k < 4; ++k)
#pragma unroll
                for (int j = 0; j < 8; ++j) y[k][j] = cb[j];
#pragma unroll
            for (int i = 0; i < 7; ++i) { float xv[8]; CVT8(xv, rw[4 * hf + i]);
#pragma unroll
                for (int k = 0; k < 4; ++k) { const int tap = i - k; if (tap >= 0 && tap < 4) {
#pragma unroll
                    for (int j = 0; j < 8; ++j) y[k][j] += cw[tap][j] * xv[j]; } } }
#pragma unroll
            for (int k = 0; k < 4; ++k) { const bool valid = (t0 + l0 + 4 * hf + k) >= 0;
#pragma unroll
                for (int j = 0; j < 8; ++j) y[k][j] = valid ? siluf(y[k][j]) : 0.f; }
#pragma unroll
            for (int j = 0; j < 8; ++j) { u32x2 o; o.x = pk2(y[0][j], y[1][j]); o.y = pk2(y[2][j], y[3][j]); *(LAS u32x2*)(T + (oct * 8 + j) * PITCH + (l0 + 4 * hf) * 2) = o; }
        }
        __syncthreads();
        unsigned char* ximg = IMG + IMG_XS_BASE + ((size_t)bc * 16 + h0) * 16384;
#pragma unroll
        for (int k = 0; k < 8; ++k) { const int piece = tid + 512 * k, row = piece >> 4, k16 = piece & 15; const u32x4 v = *(const LAS u32x4*)(T + row * PITCH + k16 * 16);
            *(u32x4*)(ximg + row * 256 + k16 * 16) = v; }
        __syncthreads();
    }
}

__device__ __forceinline__ void ssd_item(const Params& P, unsigned char* ldsg, int b, int h) {
    LAS unsigned char* lds = (LAS unsigned char*)ldsg;
    const int tid = threadIdx.x, lane = tid & 63, w = __builtin_amdgcn_readfirstlane(tid >> 6), r = lane & 15, q = lane >> 4;
    const int g = h >> 3;
    LAS unsigned char* sB = lds; LAS unsigned char* sBT = lds + 34816; LAS unsigned char* sC = lds + 69632; LAS unsigned char* sX = lds + 104448; LAS unsigned char* sP = lds + 121856;
    LAS float* sDt = (LAS float*)(lds + 139264); LAS float* sCs = sDt + 128; LAS float* sF = sDt + 256;
    const bf16_t* proj = (const bf16_t*)(P.ws + WS_PROJ);
    bf16_t* mix = (bf16_t*)(P.ws + WS_MIX); float* ssqs = (float*)(P.ws + WS_SSQS);
    const unsigned char* IMG = (const unsigned char*)P.out;
    const float Dh = P.ssd_d[h];
    f32x4 acch[4];
#pragma unroll
    for (int i = 0; i < 4; ++i) acch[i] = (f32x4){0.f, 0.f, 0.f, 0.f};
    u32x4 pf[14], pfs;
#define SSD_ISSUE(cc) do { const int bc_ = b * 17 + (cc); const unsigned char* gimg_ = IMG + ((size_t)bc_ * 2 + g) * IMG_G; const unsigned char* ximg_ = IMG + IMG_XS_BASE + ((size_t)bc_ * 16 + h) * 16384; \
        _Pragma("unroll") for (int k_ = 0; k_ < 12; ++k_) pf[k_] = *(const u32x4*)(gimg_ + (size_t)(tid + 512 * k_) * 16); \
        _Pragma("unroll") for (int k_ = 0; k_ < 2; ++k_) pf[12 + k_] = *(const u32x4*)(ximg_ + (size_t)(tid + 512 * k_) * 16); \
        if (tid < 96) pfs = *(const u32x4*)(IMG + IMG_SC_BASE + ((size_t)bc_ * 16 + h) * 1536 + tid * 16); } while (0)
    SSD_ISSUE(0);
    for (int c = 0; c < 17; ++c) {
#pragma unroll
        for (int k = 0; k < 12; ++k) { const int pc = (tid + 512 * k) & 2047; *(LAS u32x4*)(lds + (k >> 2) * 34816 + (pc >> 4) * PITCH + (pc & 15) * 16) = pf[k]; }
#pragma unroll
        for (int k = 0; k < 2; ++k) { const int pc = tid + 512 * k; *(LAS u32x4*)(sX + (pc >> 4) * PITCH + (pc & 15) * 16) = pf[12 + k]; }
        if (tid < 96) *(LAS u32x4*)((LAS unsigned char*)sDt + tid * 16) = pfs;
        __syncthreads();
        u32x2 zr[4];
        const int lt = (w & 1) ? 7 - (w >> 1) : (w >> 1);
        if (c > 0) { const size_t mrow_ = (size_t)b * SEQ + 128 * (c - 1) + 16 * lt + r;
#pragma unroll
            for (int rt = 0; rt < 4; ++rt) zr[rt] = *(const u32x2*)(proj + mrow_ * NPROJ + COL_Z + h * 64 + 16 * rt + 4 * q); }
        if (c < 16) SSD_ISSUE(c + 1);
        if (c > 0) {
            const int l = 16 * lt + r; const float cs_l = sCs[l];
            const size_t mrow = (size_t)b * SEQ + 128 * (c - 1) + l;
            bf16x8 cf[4];
#pragma unroll
            for (int ks = 0; ks < 4; ++ks) cf[ks] = *(const LAS bf16x8*)(sC + l * PITCH + ks * 64 + q * 16);
            f32x4 accy[4];
#pragma unroll
            for (int rt = 0; rt < 4; ++rt) accy[rt] = (f32x4){0.f, 0.f, 0.f, 0.f};
#pragma unroll
            for (int rt = 0; rt < 4; ++rt)
#pragma unroll
                for (int ks = 0; ks < 4; ++ks) { const bf16x8 a = *(const LAS bf16x8*)(sP + (16 * rt + r) * PITCH + ks * 64 + q * 16); accy[rt] = MFMA16(a, cf[ks], accy[rt]); }
            { const float e = __expf(cs_l);
#pragma unroll
              for (int rt = 0; rt < 4; ++rt) accy[rt] *= e; }
            const int stmax = (lt | 1);
            for (int st = 0; st <= stmax; ++st) {
                f32x4 a4 = (f32x4){0.f, 0.f, 0.f, 0.f};
                if (st <= lt) {
#pragma unroll
                    for (int ks = 0; ks < 4; ++ks) { const bf16x8 a = *(const LAS bf16x8*)(sB + (16 * st + r) * PITCH + ks * 64 + q * 16); a4 = MFMA16(a, cf[ks], a4); }
                }
                float mv[4]; const f32x4 csv = *(const LAS f32x4*)(sCs + 16 * st + 4 * q), dtv = *(const LAS f32x4*)(sDt + 16 * st + 4 * q);
#pragma unroll
                for (int j = 0; j < 4; ++j) { const int s = 16 * st + 4 * q + j; mv[j] = (s <= l) ? a4[j] * __expf(cs_l - csv[j]) * dtv[j] : 0.f; }
                u32x2 o; o.x = pk2(mv[0], mv[1]); o.y = pk2(mv[2], mv[3]);
                *(LAS u32x2*)(sC + l * PITCH + (16 * st + 4 * q) * 2) = o;
            }
            LDS_WAIT();
            for (int ks = 0; ks <= (lt >> 1); ++ks) { const bf16x8 mb = *(const LAS bf16x8*)(sC + l * PITCH + ks * 64 + q * 16);
#pragma unroll
                for (int rt = 0; rt < 4; ++rt) { const bf16x8 a = *(const LAS bf16x8*)(sX + (16 * rt + r) * PITCH + ks * 64 + q * 16); accy[rt] = MFMA16(a, mb, accy[rt]); } }
            { float ss = 0.f;
#pragma unroll
              for (int rt = 0; rt < 4; ++rt) { const int p0 = 16 * rt + 4 * q;
                  const float z[4] = {bflo(zr[rt].x), bfhi(zr[rt].x), bflo(zr[rt].y), bfhi(zr[rt].y)}; float gv[4];
#pragma unroll
                  for (int j = 0; j < 4; ++j) { const float xs = bf2f(*(const LAS unsigned short*)(sX + (p0 + j) * PITCH + l * 2)); const float yv = accy[rt][j] + Dh * xs; gv[j] = yv * z[j]; ss += gv[j] * gv[j]; }
                  u32x2 o; o.x = pk2(gv[0], gv[1]); o.y = pk2(gv[2], gv[3]); *(u32x2*)(mix + mrow * DMIX + h * 64 + p0) = o; }
              ss += __shfl_xor(ss, 16); ss += __shfl_xor(ss, 32);
              if (q == 0) ssqs[mrow * 16 + h] = ss; }
        }
        if (c < 16) {
            const float cd = __expf(sCs[127]);
#pragma unroll
            for (int ct = 0; ct < 4; ++ct) acch[ct] *= cd;
#pragma unroll
            for (int ks = 0; ks < 4; ++ks) { const u32x4 ar = *(const LAS u32x4*)(sBT + (16 * w + r) * PITCH + ks * 64 + q * 16);
                const f32x4 f0 = *(const LAS f32x4*)(sF + ks * 32 + q * 8), f1 = *(const LAS f32x4*)(sF + ks * 32 + q * 8 + 4);
                u32x4 o; o.x = pk2(bflo(ar.x) * f0[0], bfhi(ar.x) * f0[1]); o.y = pk2(bflo(ar.y) * f0[2], bfhi(ar.y) * f0[3]); o.z = pk2(bflo(ar.z) * f1[0], bfhi(ar.z) * f1[1]); o.w = pk2(bflo(ar.w) * f1[2], bfhi(ar.w) * f1[3]);
                const bf16x8 a = __builtin_bit_cast(bf16x8, o);
#pragma unroll
                for (int ct = 0; ct < 4; ++ct) { const bf16x8 bx = *(const LAS bf16x8*)(sX + (16 * ct + r) * PITCH + ks * 64 + q * 16); acch[ct] = MFMA16(a, bx, acch[ct]); } }
        }
        __syncthreads();
        if (c < 16) {
#pragma unroll
            for (int ct = 0; ct < 4; ++ct) { u32x2 o; o.x = pk2(acch[ct][0], acch[ct][1]); o.y = pk2(acch[ct][2], acch[ct][3]); *(LAS u32x2*)(sP + (16 * ct + r) * PITCH + (16 * w + 4 * q) * 2) = o; }
        }
    }
#undef SSD_ISSUE
    __syncthreads();
}

__device__ __forceinline__ float one_minus_exp(float t) {
    const float big = 1.0f - __expf(t);
    const float small = -t * (1.0f + t * (0.5f + t * (0.16666667f + t * (0.041666668f + t * 0.008333334f))));
    return t > -0.25f ? small : big;
}
__device__ __forceinline__ void lru_item(const Params& P, unsigned char* ldsg, int b, int n) {
    LAS unsigned char* lds = (LAS unsigned char*)ldsg;
    const int tid = threadIdx.x, lane = tid & 63, w = __builtin_amdgcn_readfirstlane(tid >> 6), r = lane & 15, q = lane >> 4;
    constexpr int FP = 68, XBP = 144;
    LAS float* sXr = (LAS float*)lds; LAS float* sA = (LAS float*)(lds + 34816); LAS float* sM = (LAS float*)(lds + 69632);
    LAS unsigned char* sXb = lds + 104448; LAS float* sSegA = (LAS float*)(lds + 122880); LAS float* sSegH = sSegA + 512; LAS float* sCarry = sSegH + 512;
    const bf16_t* proj = (const bf16_t*)(P.ws + WS_PROJ); bf16_t* mix = (bf16_t*)(P.ws + WS_MIX); float* ssql = (float*)(P.ws + WS_SSQL);
    const int which = w >> 2, ct = w & 3, cg_ = 16 * ct + r, chan = 64 * n + cg_;
    bf16x8 bfrag[2];
    { const float* Wsrc = (which ? P.lru_wx : P.lru_wa) + (size_t)n * 4096;
#pragma unroll
      for (int ks = 0; ks < 2; ++ks) { float v[8];
#pragma unroll
          for (int j = 0; j < 8; ++j) v[j] = Wsrc[(ks * 32 + q * 8 + j) * 64 + cg_];
          u32x4 o; o.x = pk2(v[0], v[1]); o.y = pk2(v[2], v[3]); o.z = pk2(v[4], v[5]); o.w = pk2(v[6], v[7]); bfrag[ks] = __builtin_bit_cast(bf16x8, o); } }
    const float gb2 = -1.4426950408889634f * (which ? P.lru_bx[chan] : P.lru_ba[chan]);
    const float spl8 = -8.0f * 1.4426950408889634f * log1pf(__expf(-P.lru_lambda[chan]));
    const int so = tid & 7, lq = tid >> 3, sch = 64 * n + 8 * so;
    float cw[4][8], cb[8];
#pragma unroll
    for (int k = 0; k < 4; ++k) { const f32x4 a0 = *(const f32x4*)(P.lru_conv_w + k * 1024 + sch), a1 = *(const f32x4*)(P.lru_conv_w + k * 1024 + sch + 4);
#pragma unroll
        for (int j = 0; j < 4; ++j) { cw[k][j] = a0[j]; cw[k][4 + j] = a1[j]; } }
    { const f32x4 b0 = *(const f32x4*)(P.lru_conv_b + sch), b1 = *(const f32x4*)(P.lru_conv_b + sch + 4);
#pragma unroll
      for (int j = 0; j < 4; ++j) { cb[j] = b0[j]; cb[4 + j] = b1[j]; } }
    if (tid < 64) sCarry[tid] = 0.f;
    u32x4 raw[2][4];
#define LRU_ISSUE(cc) do { const int t0_ = (cc) == 0 ? -112 : NMETA + 128 * ((cc) - 1); \
        _Pragma("unroll") for (int hh_ = 0; hh_ < 2; ++hh_) _Pragma("unroll") for (int k_ = 0; k_ < 4; ++k_) { const int tk_ = t0_ + lq + 64 * hh_ - 3 + k_; \
            const u32x4 ld_ = *(const u32x4*)(proj + (size_t)tok_row(b, tk_ < 0 ? 0 : tk_) * NPROJ + COL_XLRU + sch); raw[hh_][k_] = tk_ >= 0 ? ld_ : (u32x4){0u, 0u, 0u, 0u}; } } while (0)
    LRU_ISSUE(0);
    for (int c = 0; c < 17; ++c) {
        const int t0 = c == 0 ? -112 : NMETA + 128 * (c - 1);
        const int lb = 16 * w;
        unsigned short gt[16];
        if (c > 0) {
#pragma unroll
            for (int i = 0; i < 16; ++i) gt[i] = proj[((size_t)b * SEQ + 128 * (c - 1) + lb + i) * NPROJ + COL_GATE + 64 * n + lane];
        }
#pragma unroll
        for (int hh = 0; hh < 2; ++hh) {
            const int l = lq + 64 * hh, t = t0 + l; float y[8];
#pragma unroll
            for (int j = 0; j < 8; ++j) y[j] = cb[j];
#pragma unroll
            for (int k = 0; k < 4; ++k) { float xv[8]; CVT8(xv, raw[hh][k]);
#pragma unroll
                for (int j = 0; j < 8; ++j) y[j] += cw[k][j] * xv[j]; }
            if (t < 0) {
#pragma unroll
                for (int j = 0; j < 8; ++j) y[j] = 0.f; }
            *(LAS f32x4*)(sXr + l * FP + 8 * so) = (f32x4){y[0], y[1], y[2], y[3]}; *(LAS f32x4*)(sXr + l * FP + 8 * so + 4) = (f32x4){y[4], y[5], y[6], y[7]};
            u32x4 o; o.x = pk2(y[0], y[1]); o.y = pk2(y[2], y[3]); o.z = pk2(y[4], y[5]); o.w = pk2(y[6], y[7]);
            *(LAS u32x4*)(sXb + l * XBP + so * 16) = o;
        }
        if (c < 16) LRU_ISSUE(c + 1);
        __syncthreads();
        if (which == 0) {
#pragma unroll 2
            for (int rt = 0; rt < 8; ++rt) {
                f32x4 a4 = (f32x4){0.f, 0.f, 0.f, 0.f};
#pragma unroll
                for (int ks = 0; ks < 2; ++ks) { const bf16x8 a = *(const LAS bf16x8*)(sXb + (16 * rt + r) * XBP + ks * 64 + q * 16); a4 = MFMA16(a, bfrag[ks], a4); }
#pragma unroll
                for (int j = 0; j < 4; ++j) { const int l = 16 * rt + 4 * q + j; const float gte = __builtin_amdgcn_rcpf(1.0f + __builtin_amdgcn_exp2f(__builtin_fmaf(a4[j], -1.4426950408889634f, gb2)));
                    const float av = __builtin_amdgcn_exp2f(gte * spl8);
                    sA[l * FP + cg_] = av; sM[l * FP + cg_] = __builtin_amdgcn_sqrtf(__builtin_fmaxf(__builtin_fmaf(-av, av, 1.0f), 0.f)); }
            }
            if (c == 0) {
#pragma unroll
                for (int rt = 0; rt < 7; ++rt)
#pragma unroll
                    for (int j = 0; j < 4; ++j) sA[(16 * rt + 4 * q + j) * FP + cg_] = 1.0f; }
        } else {
#pragma unroll 2
            for (int rt = 0; rt < 8; ++rt) {
                float xr4[4];
#pragma unroll
                for (int j = 0; j < 4; ++j) xr4[j] = sXr[(16 * rt + 4 * q + j) * FP + cg_];
                f32x4 a4 = (f32x4){0.f, 0.f, 0.f, 0.f};
#pragma unroll
                for (int ks = 0; ks < 2; ++ks) { const bf16x8 a = *(const LAS bf16x8*)(sXb + (16 * rt + r) * XBP + ks * 64 + q * 16); a4 = MFMA16(a, bfrag[ks], a4); }
#pragma unroll
                for (int j = 0; j < 4; ++j) { const float gte = __builtin_amdgcn_rcpf(1.0f + __builtin_amdgcn_exp2f(__builtin_fmaf(a4[j], -1.4426950408889634f, gb2)));
                    sXr[(16 * rt + 4 * q + j) * FP + cg_] = gte * xr4[j]; }
            }
        }
        __syncthreads();
        { float av[16], uv[16];
#pragma unroll
          for (int i = 0; i < 16; ++i) { const int o = (lb + i) * FP + lane; av[i] = sA[o]; uv[i] = sM[o] * sXr[o]; }
          float hl = 0.f, ap = 1.f;
#pragma unroll
          for (int i = 0; i < 16; ++i) { const int o = (lb + i) * FP + lane; hl = av[i] * hl + uv[i]; ap *= av[i]; sXr[o] = hl; sM[o] = ap; }
          sSegA[w * 64 + lane] = ap; sSegH[w * 64 + lane] = hl; }
        __syncthreads();
        float carry = sCarry[lane];
        for (int s = 0; s < w; ++s) carry = sSegA[s * 64 + lane] * carry + sSegH[s * 64 + lane];
        float hend = 0.f;
#pragma unroll
        for (int i = 0; i < 16; ++i) { const int o = (lb + i) * FP + lane; const float hv = sXr[o] + sM[o] * carry; hend = hv;
            if (c > 0) { const size_t mrow = (size_t)b * SEQ + 128 * (c - 1) + lb + i; const float yv = bf2f(gt[i]) * hv;
                mix[mrow * DMIX + 1024 + 64 * n + lane] = f2bf(yv); sA[o] = yv * yv; } }
        __syncthreads();
        if (w == 7) sCarry[lane] = hend;
        if (c > 0) { const int row = tid >> 2, part = tid & 3; const LAS f32x4* pq = (const LAS f32x4*)(sA + row * FP + part * 16);
            const f32x4 s0 = pq[0], s1 = pq[1], s2 = pq[2], s3 = pq[3];
            float ss = (((s0[0] + s0[1]) + (s0[2] + s0[3])) + ((s1[0] + s1[1]) + (s1[2] + s1[3]))) + (((s2[0] + s2[1]) + (s2[2] + s2[3])) + ((s3[0] + s3[1]) + (s3[2] + s3[3])));
            ss = dpp_add(ss, 0); ss = dpp_add(ss, 1);
            if (part == 0) ssql[((size_t)b * SEQ + 128 * (c - 1) + row) * 16 + n] = ss; }
    }
#undef LRU_ISSUE
    __syncthreads();
}
#define XB_TMO      128
#define XB_XCNT(j)  (256  + 64 * (j))
#define XB_XSUB(j)  (1280 + 64 * (j))
#define XB_XGEN(j)  (2304 + 64 * (j))
#define XB_TOP      3328
#define XB_TOPGEN   3392
#define XCD_BAR_WORDS 3456
#define XB_SPIN_CAP (1u << 18)
__device__ __forceinline__ unsigned xb_ld(unsigned* p)              { return __hip_atomic_load(p, __ATOMIC_RELAXED, __HIP_MEMORY_SCOPE_AGENT); }
__device__ __forceinline__ unsigned xb_add(unsigned* p, unsigned v) { return __hip_atomic_fetch_add(p, v, __ATOMIC_RELAXED, __HIP_MEMORY_SCOPE_AGENT); }
__device__ __forceinline__ unsigned xb_xcc_id() { return (unsigned)__builtin_amdgcn_s_getreg((3 << 11) | 20) & 0xFu; }
#define XB_SPIN(cond, bar) do { unsigned _sp = 0; while (cond) { __builtin_amdgcn_s_sleep(1); \
    if ((++_sp & 255u) == 0u) { if (xb_ld(&(bar)[XB_TMO])) break; if (_sp > XB_SPIN_CAP) { atomicAdd(&(bar)[XB_TMO], 1u); break; } } } } while (0)
struct XcdBarrier { unsigned* bar; unsigned x; volatile LAS unsigned* st; };
__device__ __forceinline__ XcdBarrier xcd_barrier_post(unsigned* bar, volatile LAS unsigned* st) {
    XcdBarrier b; b.bar = bar; b.x = xb_xcc_id(); b.st = st;
    if (threadIdx.x == 0) (void)xb_add(&bar[XB_XCNT(b.x)], 1u);
    return b;
}
__device__ __forceinline__ void xcd_barrier_complete(unsigned* bar, unsigned x, unsigned& nloc, unsigned& nx) {
    const unsigned G = gridDim.x * gridDim.y * gridDim.z;
    unsigned sum, cnt, mine, sp = 0u;
    for (;;) {
        sum = 0u; cnt = 0u; mine = 0u;
#pragma unroll
        for (unsigned j = 0; j < 16; ++j) { const unsigned c = xb_ld(&bar[XB_XCNT(j)]); sum += c; cnt += (c > 0u) ? 1u : 0u; mine = (j == x) ? c : mine; }
        if (sum == G) break;
        __builtin_amdgcn_s_sleep(1);
        if ((++sp & 255u) == 0u) { if (xb_ld(&bar[XB_TMO])) break; if (sp > XB_SPIN_CAP) { atomicAdd(&bar[XB_TMO], 1u); break; } }
    }
    nloc = mine > 0u ? mine : 1u; nx = cnt > 0u ? cnt : 1u;
}
__device__ __forceinline__ void xcd_barrier(const XcdBarrier& b) {
    asm volatile("s_waitcnt vmcnt(0)" ::: "memory");
    __syncthreads();
    if (threadIdx.x == 0) {
        unsigned* bar = b.bar;
        __builtin_amdgcn_s_waitcnt(0);
        unsigned nloc = b.st[0], nx = b.st[1];
        if (nloc == 0u) { xcd_barrier_complete(bar, b.x, nloc, nx); b.st[0] = nloc; b.st[1] = nx; }
        const unsigned old = xb_add(&bar[XB_XSUB(b.x)], 1u);
        const unsigned gen = old / nloc;
        if (old + 1u == (gen + 1u) * nloc) {
            __builtin_amdgcn_fence(__ATOMIC_RELEASE, "agent");
            asm volatile("s_waitcnt vmcnt(0)" ::: "memory");
            const unsigned og = xb_add(&bar[XB_TOP], 1u);
            const unsigned tg = og / nx;
            if (og + 1u == (tg + 1u) * nx) xb_add(&bar[XB_TOPGEN], 1u);
            else XB_SPIN(xb_ld(&bar[XB_TOPGEN]) == tg, bar);
            __builtin_amdgcn_fence(__ATOMIC_ACQUIRE, "agent");
            xb_add(&bar[XB_XGEN(b.x)], 1u);
            asm volatile("s_waitcnt vmcnt(0)" ::: "memory");
        } else {
            XB_SPIN(xb_ld(&bar[XB_XGEN(b.x)]) == gen, bar);
            __builtin_amdgcn_fence(__ATOMIC_ACQUIRE, "agent");
            asm volatile("s_waitcnt vmcnt(0)" ::: "memory");
        }
    }
    __syncthreads();
}

#ifndef PH_MASK
#define PH_MASK 255
#endif
#ifndef REP1
#define REP1 1
#define REP2 1
#define REP3 1
#define REP4 1
#define REP5 1
#endif
constexpr int NPHASE = 7;
constexpr size_t WS_CNT = WS_BAR + 16384;
__global__ void __launch_bounds__(NTHREADS, 2) hymba_fwd(Params P) {
    extern __shared__ __attribute__((aligned(16))) unsigned char lds[];
    cg::grid_group grid = cg::this_grid();
    const int lo = P.ph_lo, hi = P.ph_hi, G = gridDim.x, blk = blockIdx.x;
    volatile LAS unsigned* MISC = (volatile LAS unsigned*)((LAS unsigned char*)lds + (LDS_BYTES - 64));
    if (threadIdx.x < 2) MISC[threadIdx.x] = 0u;
    __syncthreads();
    const XcdBarrier bar = xcd_barrier_post((unsigned*)(P.ws + WS_BAR), MISC);
    if (hi > 1000) grid.sync();
#define IN(k) (((PH_MASK >> (k)) & 1) && lo <= (k) && (k) < hi)
#define SEAM(k) do { if (lo <= (k) && (k) + 1 < hi) xcd_barrier(bar); } while (0)
    PG8_LAS unsigned char* ldsp = (PG8_LAS unsigned char*)lds;
    bf16_t* proj = (bf16_t*)(P.ws + WS_PROJ);
    if (IN(0)) { p0_prologue(P, lds); __syncthreads(); }
    SEAM(0);
    if (IN(1)) for (int rep = 0; rep < REP1; ++rep) {
        pg8::Gemm g{(const bf16_t*)P.out, (const bf16_t*)(P.ws + WS_WIN), M1, N1, D}; pg8::StaticOrder S; S.init(M1, N1, G, blk, WGM_P1);
        pg8::EpiProj E{proj, (float*)(P.ws + WS_DTRAW), (const float*)(P.ws + WS_RSTD1)};
        f32x4 accz[2][2][4][2]; pg8::gemm_phase<pg8::EpiProj, pg8::StaticOrder, true, true>(ldsp, g, S, E, accz);
        __syncthreads();
    }
    SEAM(1);
    if (IN(2)) for (int rep = 0; rep < REP2; ++rep) {
        weight_items(P, lds, 1); __syncthreads();
        if (G == 256) {
            constexpr int NBC = BATCH * 17, NX = 4 * NBC;
            for (int k = 0; k < 6; ++k) { int kind = -1, bc = 0;
                if (k < 3) { const int xi = blk + 256 * k; if (k < 2 || blk < 32) { if (xi < NX) { kind = 4 + xi / NBC; bc = xi % NBC; } } }
                else { int bi = -1; const int j = blk - 32, kk = k - 3;
                    if (blk < 32) { if (kk == 0) bi = blk; } else if (kk < 2) bi = 32 + 224 * kk + j; else if (j < 64) bi = 32 + 448 + j;
                    if (bi >= 0 && bi < NX) { kind = bi / NBC; bc = bi % NBC; } }
                if (kind >= 0) ssd_prep_item(P, lds, bc / 17, bc % 17, kind); }
        } else
        for (int it = blk; it < BATCH * 17 * 8; it += G) { const int bc = it % (BATCH * 17); ssd_prep_item(P, lds, bc / 17, bc % 17, it / (BATCH * 17)); }
    }
    SEAM(2);
    if (IN(3)) for (int rep = 0; rep < REP3; ++rep) {
        for (int v = blk; v < 256; v += G) if (((v >> 3) & 1) == 0) { const int xcd = v & 7, slot = v >> 4; ssd_item(P, lds, (xcd >> 1) | ((slot >> 3) << 2), 8 * (xcd & 1) + (slot & 7)); }
        for (int v = blk; v < 256; v += G) if (((v >> 3) & 1) == 1) { const int idx = ((v >> 4) << 3) | (v & 7); lru_item(P, lds, idx >> 4, idx & 15); }
    }
    f32x4 accI[2][2][4][2], accJ[2][2][4][2];
#define PRELOAD_TILE(accI, src, Ncols) do { pg8::StaticOrder S_; S_.init(MROWS, (Ncols), G, blk); pg8::Unit u_; if (S_.next(0, u_)) { \
        const int wid_ = threadIdx.x >> 6, lane_ = threadIdx.x & 63, wr_ = wid_ >> 2, wc_ = wid_ & 3, fr_ = lane_ & 15, fq_ = lane_ >> 4; \
        _Pragma("unroll") for (int ai = 0; ai < 2; ++ai) _Pragma("unroll") for (int bj = 0; bj < 2; ++bj) _Pragma("unroll") for (int m = 0; m < 4; ++m) _Pragma("unroll") for (int n = 0; n < 2; ++n) \
            accI[ai][bj][m][n] = *(const f32x4*)((src) + (size_t)(u_.pm * 256 + ai * 128 + wr_ * 64 + m * 16 + fr_) * D + u_.pn * 256 + bj * 128 + wc_ * 32 + n * 16 + 4 * fq_); } } while (0)
    if (IN(4)) PRELOAD_TILE(accI, P.x, D);
    SEAM(3);
    if (IN(4)) {
        pg8::Gemm g{(const bf16_t*)(P.ws + WS_MIX), (const bf16_t*)(P.ws + WS_WOUT), MROWS, D, DMIX}; pg8::StaticOrder S; S.init(MROWS, D, G, blk);
        pg8::Unit u0;
        if (S.next(0, u0) && threadIdx.x < 256) {
            const int row = u0.pm * 256 + threadIdx.x; const f32x4* a = (const f32x4*)((const float*)(P.ws + WS_SSQS) + (size_t)row * 16); const f32x4* l4 = (const f32x4*)((const float*)(P.ws + WS_SSQL) + (size_t)row * 16);
            const f32x4 a0 = a[0], a1 = a[1], a2 = a[2], a3 = a[3], l0 = l4[0], l1 = l4[1], l2 = l4[2], l3 = l4[3];
            const float g0 = ((a0[0] + a0[1]) + (a0[2] + a0[3])) + ((a1[0] + a1[1]) + (a1[2] + a1[3])), g1 = ((a2[0] + a2[1]) + (a2[2] + a2[3])) + ((a3[0] + a3[1]) + (a3[2] + a3[3]));
            const float ls = (((l0[0] + l0[1]) + (l0[2] + l0[3])) + ((l1[0] + l1[1]) + (l1[2] + l1[3]))) + (((l2[0] + l2[1]) + (l2[2] + l2[3])) + ((l3[0] + l3[1]) + (l3[2] + l3[3])));
            const float r0 = __frsqrt_rn(g0 * (1.0f / 512.f) + EPS), r1 = __frsqrt_rn(g1 * (1.0f / 512.f) + EPS), rl = __frsqrt_rn(ls * (1.0f / 1024.f) + EPS);
            *(PG8_LAS f32x4*)(ldsp + pg8::STAGE_BYTES + threadIdx.x * 16) = (f32x4){r0 / r1, r1 / rl, rl, __builtin_amdgcn_rcpf(r0)};
        }
        __syncthreads();
        { const int wid_ = threadIdx.x >> 6, lane_ = threadIdx.x & 63, wr_ = wid_ >> 2, fr_ = lane_ & 15;
#pragma unroll
          for (int ai = 0; ai < 2; ++ai)
#pragma unroll
              for (int m = 0; m < 4; ++m) { const float iv = (*(const PG8_LAS f32x4*)(ldsp + pg8::STAGE_BYTES + (ai * 128 + wr_ * 64 + m * 16 + fr_) * 16))[3];
#pragma unroll
                  for (int bj = 0; bj < 2; ++bj)
#pragma unroll
                      for (int n = 0; n < 2; ++n) accI[ai][bj][m][n] *= iv; } }
        pg8::EpiOut E{(bf16_t*)(P.ws + WS_H1B), (float*)(P.ws + WS_SSQ2)};
        pg8::gemm_phase<pg8::EpiOut, pg8::StaticOrder, false, true, true>(ldsp, g, S, E, accI);
        __syncthreads();
    }
    SEAM(4);
    if (IN(5)) for (int rep = 0; rep < REP5; ++rep) {
        pg8::Gemm g{(const bf16_t*)(P.ws + WS_H1B), (const bf16_t*)(P.ws + WS_WGU), MROWS, NGU, D}; pg8::StaticOrder S; S.init(MROWS, NGU, G, blk, WGM_P4);
        pg8::EpiGU E{(bf16_t*)(P.ws + WS_ACT), (const float*)(P.ws + WS_SSQ2)};
        f32x4 accz[2][2][4][2]; pg8::gemm_phase<pg8::EpiGU, pg8::StaticOrder, true, true>(ldsp, g, S, E, accz);
        __syncthreads();
    }
    if (IN(6)) { pg8::StaticOrder S_; S_.init(MROWS, D, G, blk); pg8::Unit u_; if (S_.next(0, u_)) {
        const int wid_ = threadIdx.x >> 6, lane_ = threadIdx.x & 63, wr_ = wid_ >> 2, wc_ = wid_ & 3, fr_ = lane_ & 15, fq_ = lane_ >> 4; const bf16_t* h1b_ = (const bf16_t*)(P.ws + WS_H1B);
#pragma unroll
        for (int ai = 0; ai < 2; ++ai)
#pragma unroll
            for (int bj = 0; bj < 2; ++bj)
#pragma unroll
                for (int m = 0; m < 4; ++m)
#pragma unroll
                    for (int n = 0; n < 2; ++n) { const u32x2 rv = *(const u32x2*)(h1b_ + (size_t)(u_.pm * 256 + ai * 128 + wr_ * 64 + m * 16 + fr_) * D + u_.pn * 256 + bj * 128 + wc_ * 32 + n * 16 + 4 * fq_);
                        accJ[ai][bj][m][n] = (f32x4){bflo(rv.x), bfhi(rv.x), bflo(rv.y), bfhi(rv.y)}; } } }
    SEAM(5);
    if (IN(6)) {
        pg8::Gemm g{(const bf16_t*)(P.ws + WS_ACT), (const bf16_t*)(P.ws + WS_WD), MROWS, D, DFF}; pg8::StaticOrder S; S.init(MROWS, D, G, blk);
        pg8::EpiDownNorm E{P.out, P.final_norm_w, (float*)(P.ws + WS_SSQ3), (unsigned*)(P.ws + WS_CNT)};
        pg8::gemm_phase<pg8::EpiDownNorm, pg8::StaticOrder, false, true, true>(ldsp, g, S, E, accJ);
        __syncthreads();
    }
#undef IN
#undef SEAM
}

extern "C" void kernel_launch(void* const* d_in, const int* in_sizes, int n_in, void* d_out, int out_size, void* d_ws, size_t ws_size, hipStream_t stream) {
    static int grid = 0;
    if (grid == 0) {
        if (n_in != 24 || out_size != MROWS * D || ws_size < WS_BAR + 32768) { fprintf(stderr, "kernel_launch: unexpected problem shape (n_in %d, out %d, ws %zu)\n", n_in, out_size, ws_size); grid = -1; return; }
        int dev = 0, cus = 0, per_cu = 0;
        if (hipGetDevice(&dev) != hipSuccess || hipDeviceGetAttribute(&cus, hipDeviceAttributeMultiprocessorCount, dev) != hipSuccess) { grid = -1; return; }
        if (hipFuncSetAttribute((const void*)hymba_fwd, hipFuncAttributeMaxDynamicSharedMemorySize, LDS_BYTES) != hipSuccess) { fprintf(stderr, "kernel_launch: hipFuncSetAttribute failed\n"); grid = -1; return; }
        if (hipOccupancyMaxActiveBlocksPerMultiprocessor(&per_cu, (const void*)hymba_fwd, NTHREADS, LDS_BYTES) != hipSuccess || per_cu < 1) { fprintf(stderr, "kernel_launch: occupancy query says %d blocks per CU\n", per_cu); (void)hipGetLastError(); }
        grid = cus;
        if (grid != 256) fprintf(stderr, "kernel_launch: %d CUs; the one-unit-per-workgroup GEMM phases assume 256\n", grid);
    }
    if (grid < 0) return;
    Params p{};
    const float** pp = (const float**)&p;
    for (int i = 0; i < 24; ++i) pp[i] = (const float*)d_in[i];
    p.out = (float*)d_out; p.ws = (unsigned char*)d_ws;
    (void)hipMemsetAsync((unsigned char*)d_ws + WS_BAR, 0, 32768, stream);
#if MK_LAUNCHES == 1
    p.ph_lo = 0; p.ph_hi = NPHASE;
    void* args[] = {&p};
    hipError_t e = hipLaunchCooperativeKernel((void*)hymba_fwd, dim3(grid), dim3(NTHREADS), args, LDS_BYTES, stream);
    if (e != hipSuccess) fprintf(stderr, "kernel_launch: cooperative launch failed: %s\n", hipGetErrorString(e));
#else
    for (int ph = 0; ph < NPHASE; ++ph) { p.ph_lo = ph; p.ph_hi = ph + 1; hipLaunchKernelGGL(hymba_fwd, dim3(grid), dim3(NTHREADS), LDS_BYTES, stream, p); }
#endif
}
```

```cpp
#ifndef WGM_P1
#define WGM_P1 2
#define WGM_P4 2
#endif
#include <hip/hip_runtime.h>
#include <hip/hip_cooperative_groups.h>
#include <cstdio>
#include <cstdint>
namespace cg = cooperative_groups;

#ifndef MK_LAUNCHES
#define MK_LAUNCHES 1
#endif

constexpr int D = 1024, BATCH = 8, SEQ = 2048, NMETA = 16;
constexpr int MROWS = BATCH * SEQ;
constexpr int M1 = MROWS + 256;
constexpr int NPROJ = 4608;
constexpr int N1 = 4864;
constexpr int IN_COLS = 4624;
constexpr int DMIX = 2048, DFF = 2816, NGU = 2 * DFF;
constexpr int COL_Z = 0, COL_XBC = 1024, COL_GATE = 2560, COL_XLRU = 3584;
constexpr float EPS = 1e-6f;
constexpr size_t MiB = 1u << 20;
constexpr size_t WS_WIN = 0, WS_WOUT = 10 * MiB, WS_WGU = 14 * MiB, WS_WD = 25 * MiB;
constexpr size_t WS_RSTD1 = 31 * MiB, WS_DTRAW = 31 * MiB + 128 * 1024, WS_SSQS = 33 * MiB, WS_SSQL = 34 * MiB, WS_SSQ2 = 35 * MiB, WS_SSQ3 = 35 * MiB + 512 * 1024;
constexpr size_t WS_MIX = 36 * MiB, WS_PROJ = 100 * MiB, WS_ACT = WS_PROJ, WS_H1B = WS_PROJ + 96 * MiB;
constexpr size_t WS_END = WS_PROJ + (size_t)M1 * NPROJ * 2;
static_assert(WS_END <= 256 * MiB, "workspace map");
constexpr int LDS_BYTES = 147456;
constexpr int NTHREADS = 512;

namespace pg8 {
#define PG8_LAS __attribute__((address_space(3)))
typedef unsigned short bf16_t;
typedef short bf16x8 __attribute__((ext_vector_type(8)));
typedef float f32x4 __attribute__((ext_vector_type(4)));
typedef unsigned u32x4 __attribute__((ext_vector_type(4)));
constexpr int BM = 256, BK = 64, HALF = 128, HTB = HALF * BK * 2  , STAGE_BYTES = 8 * HTB, NXCD = 8, WGM = 4;

__host__ __device__ __forceinline__ int lds_byte(int r, int c) { const int st = (r >> 4) * 2 + (c >> 5), rr = r & 15, cc = c & 31, ob = rr * 64 + cc * 2; return st * 1024 + (ob ^ (((ob >> 9) & 1) << 5)); }
__host__ __device__ __forceinline__ void stage_rc(int b, int& R, int& C) { const int st = b / 1024, sb = b % 1024, swz = sb ^ (((sb >> 9) & 1) << 5); R = (st >> 1) * 16 + swz / 64; C = (st & 1) * 32 + (swz % 64) / 2; }
__host__ __device__ __forceinline__ int perm32(int rho) { const int n = rho >> 4, i = rho & 15; return 8 * (i >> 2) + 4 * n + (i & 3); }

struct Unit { int pm, pn; };
struct Gemm { const bf16_t* A; const bf16_t* Bt; int M, N, K; };

struct StaticOrder {
    int nM, nN, nwg, G, c, wgm;
    __host__ __device__ void init(int M, int N, int G_, int c_, int wgm_ = WGM) { nM = M / BM; nN = N / BM; nwg = nM * nN; G = G_; c = c_; wgm = wgm_; }
    __host__ __device__ bool next(int i, Unit& u) const {
        const long L = (long)i * G + c; if (L >= nwg) return false;
        int wgid = (int)L; { const int q = nwg / NXCD, r = nwg % NXCD, xcd = wgid % NXCD, off = wgid / NXCD; wgid = (xcd < r ? xcd * (q + 1) : r * (q + 1) + (xcd - r) * q) + off; }
        const int nig = wgm * nN, gid = wgid / nig, fm = gid * wgm, gsz = (nM - fm) < wgm ? (nM - fm) : wgm;
        u.pm = fm + ((wgid % nig) % gsz); u.pn = (wgid % nig) / gsz; return true;
    }
    __device__ __forceinline__ void a_ready(const Unit&) const {}
    __device__ __forceinline__ void done(const Unit&) const {}
};

__device__ __forceinline__ unsigned cvt_pk_bf16(float lo, float hi) { unsigned r; asm volatile("v_cvt_pk_bf16_f32 %0, %1, %2" : "=v"(r) : "v"(lo), "v"(hi)); return r; }
typedef unsigned u32x2 __attribute__((ext_vector_type(2)));
__device__ __forceinline__ float sigmoidf_(float x) { return __builtin_amdgcn_rcpf(1.0f + __expf(-x)); }

struct EpiProj {
    static constexpr bool PERM = true, AFTER_DRAIN = false, KHOOK = false; static constexpr int KH0 = -1, KH1 = -1;
    bf16_t* proj; float* dtraw; const float* rstd1;
    __device__ __forceinline__ void operator()(const f32x4 (&acc)[2][2][4][2], const Unit& u, int wr, int wc, int fr, int fq) const {
        const int row0 = u.pm * BM + wr * 64 + fr;
        if (u.pn == 18) {
            if (wc == 0 && fq < 2) {
#pragma unroll
                for (int ai = 0; ai < 2; ++ai)
#pragma unroll
                    for (int m = 0; m < 4; ++m) { const int row = row0 + ai * HALF + m * 16; const float s = rstd1[row]; float* dp = dtraw + (size_t)row * 16 + 8 * fq;
                        *(f32x4*)dp = acc[ai][0][m][0] * s; *(f32x4*)(dp + 4) = acc[ai][0][m][1] * s; } }
            return;
        }
        const bool isz = u.pn < 4, isg = (u.pn >= 10 && u.pn < 14);
        bf16_t* base = proj + (size_t)row0 * NPROJ + u.pn * BM + wc * 32 + 8 * fq;
        if (isz || isg) {
            const float c1 = isz ? 1.0f : 1.5957691216057308f, c3 = isz ? 0.f : 0.07135481627f;
#pragma unroll
            for (int ai = 0; ai < 2; ++ai)
#pragma unroll
                for (int m = 0; m < 4; ++m) { const float s = rstd1[row0 + ai * HALF + m * 16]; bf16_t* rowp = base + (size_t)(ai * HALF + m * 16) * NPROJ;
#pragma unroll
                    for (int bj = 0; bj < 2; ++bj) { f32x4 v0 = acc[ai][bj][m][0] * s, v1 = acc[ai][bj][m][1] * s;
#pragma unroll
                        for (int j = 0; j < 4; ++j) { v0[j] = v0[j] * sigmoidf_(v0[j] * (c1 + c3 * v0[j] * v0[j])); v1[j] = v1[j] * sigmoidf_(v1[j] * (c1 + c3 * v1[j] * v1[j])); }
                        u32x4 w; w.x = cvt_pk_bf16(v0[0], v0[1]); w.y = cvt_pk_bf16(v0[2], v0[3]); w.z = cvt_pk_bf16(v1[0], v1[1]); w.w = cvt_pk_bf16(v1[2], v1[3]);
                        __builtin_nontemporal_store(w, (u32x4*)(rowp + bj * HALF)); } }
        } else {
#pragma unroll
            for (int ai = 0; ai < 2; ++ai)
#pragma unroll
                for (int m = 0; m < 4; ++m) { const float s = rstd1[row0 + ai * HALF + m * 16]; bf16_t* rowp = base + (size_t)(ai * HALF + m * 16) * NPROJ;
#pragma unroll
                    for (int bj = 0; bj < 2; ++bj) { const f32x4 v0 = acc[ai][bj][m][0] * s, v1 = acc[ai][bj][m][1] * s;
                        u32x4 w; w.x = cvt_pk_bf16(v0[0], v0[1]); w.y = cvt_pk_bf16(v0[2], v0[3]); w.z = cvt_pk_bf16(v1[0], v1[1]); w.w = cvt_pk_bf16(v1[2], v1[3]);
                        __builtin_nontemporal_store(w, (u32x4*)(rowp + bj * HALF)); } }
        }
    }
    __device__ __forceinline__ void khook(f32x4 (&)[2][2][4][2], int, int, int, PG8_LAS unsigned char*) const {}
};
struct EpiOut {
    static constexpr bool PERM = false, AFTER_DRAIN = true, KHOOK = true; static constexpr int KH0 = 8, KH1 = 16;
    bf16_t* h1b; float* ssq2;
    __device__ __forceinline__ void khook(f32x4 (&acc)[2][2][4][2], int t, int wr, int fr, PG8_LAS unsigned char* lds) const {
        const PG8_LAS f32x4* T = (const PG8_LAS f32x4*)(lds + STAGE_BYTES);
#pragma unroll
        for (int ai = 0; ai < 2; ++ai)
#pragma unroll
            for (int m = 0; m < 4; ++m) { const f32x4 tv = T[ai * HALF + wr * 64 + m * 16 + fr]; const float s = (t == KH0) ? tv.x : tv.y;
#pragma unroll
                for (int bj = 0; bj < 2; ++bj)
#pragma unroll
                    for (int n = 0; n < 2; ++n) acc[ai][bj][m][n] *= s; }
    }
    __device__ __forceinline__ void operator()(const f32x4 (&)[2][2][4][2], const Unit&, int, int, int, int) const {}
    __device__ __forceinline__ void fused(f32x4 (&acc)[2][2][4][2], const Unit& u, int wr, int wc, int fr, int fq, PG8_LAS unsigned char* lds, int wid, int lane) const {
        const PG8_LAS f32x4* T = (const PG8_LAS f32x4*)(lds + STAGE_BYTES);
        PG8_LAS float* Pp = (PG8_LAS float*)lds;
        const int col0 = u.pn * BM + wc * 32 + 4 * fq;
#pragma unroll
        for (int ai = 0; ai < 2; ++ai) {
#pragma unroll
            for (int m = 0; m < 4; ++m) { const int r = ai * HALF + wr * 64 + m * 16 + fr; const float s = T[r].z; const size_t off = (size_t)(u.pm * BM + r) * D + col0; float ss = 0.f;
#pragma unroll
                for (int bj = 0; bj < 2; ++bj)
#pragma unroll
                    for (int n = 0; n < 2; ++n) { const size_t o = off + bj * HALF + n * 16; const f32x4 hv = acc[ai][bj][m][n] * s;
                        ss += (hv[0] * hv[0] + hv[1] * hv[1]) + (hv[2] * hv[2] + hv[3] * hv[3]);
                        u32x2 w; w.x = cvt_pk_bf16(hv[0], hv[1]); w.y = cvt_pk_bf16(hv[2], hv[3]); *(u32x2*)(h1b + o) = w; }
                ss += __shfl_xor(ss, 16); ss += __shfl_xor(ss, 32);
                if (fq == 0) Pp[r * 4 + wc] = ss; }
        }
        asm volatile("s_waitcnt lgkmcnt(0)" ::: "memory"); __builtin_amdgcn_s_barrier(); asm volatile("" ::: "memory");
        const int tid = wid * 64 + lane;
        if (tid < 256) { const f32x4 p = *(const PG8_LAS f32x4*)(Pp + tid * 4); ssq2[(size_t)(u.pm * BM + tid) * 4 + u.pn] = (p[0] + p[1]) + (p[2] + p[3]); }
    }
};
struct EpiGU {
    static constexpr bool PERM = true, AFTER_DRAIN = false, KHOOK = false; static constexpr int KH0 = -1, KH1 = -1;
    bf16_t* act; const float* ssq2;
    __device__ __forceinline__ void operator()(const f32x4 (&acc)[2][2][4][2], const Unit& u, int wr, int wc, int fr, int fq) const {
        const int row0 = u.pm * BM + wr * 64 + fr;
#pragma unroll
        for (int ai = 0; ai < 2; ++ai)
#pragma unroll
            for (int m = 0; m < 4; ++m) { const int row = row0 + ai * HALF + m * 16; const f32x4 q = *(const f32x4*)(ssq2 + (size_t)row * 4);
                const float s = __frsqrt_rn(((q[0] + q[1]) + (q[2] + q[3])) * (1.0f / D) + EPS);
                f32x4 o4[2];
#pragma unroll
                for (int n = 0; n < 2; ++n) { const f32x4 g = acc[ai][0][m][n] * s, up = acc[ai][1][m][n] * s, t = g * (-1.4426950408889634f); f32x4 e;
#pragma unroll
                    for (int j = 0; j < 4; ++j) e[j] = __builtin_amdgcn_exp2f(t[j]);
                    const f32x4 d = e + 1.0f; f32x4 rc;
#pragma unroll
                    for (int j = 0; j < 4; ++j) rc[j] = __builtin_amdgcn_rcpf(d[j]);
                    o4[n] = (g * rc) * up; }
                u32x4 w; w.x = cvt_pk_bf16(o4[0][0], o4[0][1]); w.y = cvt_pk_bf16(o4[0][2], o4[0][3]); w.z = cvt_pk_bf16(o4[1][0], o4[1][1]); w.w = cvt_pk_bf16(o4[1][2], o4[1][3]);
                __builtin_nontemporal_store(w, (u32x4*)(act + (size_t)row * DFF + u.pn * HALF + wc * 32 + 8 * fq)); }
    }
    __device__ __forceinline__ void khook(f32x4 (&)[2][2][4][2], int, int, int, PG8_LAS unsigned char*) const {}
};
struct EpiDown {
    static constexpr bool PERM = false, AFTER_DRAIN = true, KHOOK = false; static constexpr int KH0 = -1, KH1 = -1;
    float* hout; float* ssq3;
    __device__ __forceinline__ void khook(f32x4 (&)[2][2][4][2], int, int, int, PG8_LAS unsigned char*) const {}
    __device__ __forceinline__ void operator()(const f32x4 (&)[2][2][4][2], const Unit&, int, int, int, int) const {}
    __device__ __forceinline__ void fused(f32x4 (&acc)[2][2][4][2], const Unit& u, int wr, int wc, int fr, int fq, PG8_LAS unsigned char* lds, int wid, int lane) const {
        PG8_LAS float* Pp = (PG8_LAS float*)lds;
        const int col0 = u.pn * BM + wc * 32 + 4 * fq;
#pragma unroll
        for (int ai = 0; ai < 2; ++ai)
#pragma unroll
            for (int m = 0; m < 4; ++m) { const int r = ai * HALF + wr * 64 + m * 16 + fr; const size_t off = (size_t)(u.pm * BM + r) * D + col0; float ss = 0.f;
#pragma unroll
                for (int bj = 0; bj < 2; ++bj)
#pragma unroll
                    for (int n = 0; n < 2; ++n) { const size_t o = off + bj * HALF + n * 16; const f32x4 hv = *(const f32x4*)(hout + o) + acc[ai][bj][m][n];
                        *(f32x4*)(hout + o) = hv; ss += (hv[0] * hv[0] + hv[1] * hv[1]) + (hv[2] * hv[2] + hv[3] * hv[3]); }
                ss += __shfl_xor(ss, 16); ss += __shfl_xor(ss, 32);
                if (fq == 0) Pp[r * 4 + wc] = ss; }
        asm volatile("s_waitcnt lgkmcnt(0)" ::: "memory"); __builtin_amdgcn_s_barrier(); asm volatile("" ::: "memory");
        const int tid = wid * 64 + lane;
        if (tid < 256) { const f32x4 p = *(const PG8_LAS f32x4*)(Pp + tid * 4); ssq3[(size_t)(u.pm * BM + tid) * 4 + u.pn] = (p[0] + p[1]) + (p[2] + p[3]); }
    }
};

struct EpiDownNorm {
    static constexpr bool PERM = false, AFTER_DRAIN = true, KHOOK = false; static constexpr int KH0 = -1, KH1 = -1;
    float* hout; const float* fw; float* xbuf; unsigned* cnt;
    __device__ __forceinline__ void khook(f32x4 (&)[2][2][4][2], int, int, int, PG8_LAS unsigned char*) const {}
    __device__ __forceinline__ void operator()(const f32x4 (&)[2][2][4][2], const Unit&, int, int, int, int) const {}
    __device__ __forceinline__ void fused(f32x4 (&acc)[2][2][4][2], const Unit& u, int wr, int wc, int fr, int fq, PG8_LAS unsigned char* lds, int wid, int lane) const {
        PG8_LAS float* Pp = (PG8_LAS float*)lds; PG8_LAS float* Sr = (PG8_LAS float*)(lds + 8192);
        const int col0 = u.pn * BM + wc * 32 + 4 * fq;
#pragma unroll
        for (int ai = 0; ai < 2; ++ai) {
#pragma unroll
            for (int m = 0; m < 4; ++m) { const int r = ai * HALF + wr * 64 + m * 16 + fr; float ss = 0.f;
#pragma unroll
                for (int bj = 0; bj < 2; ++bj)
#pragma unroll
                    for (int n = 0; n < 2; ++n) { const f32x4 hv = acc[ai][bj][m][n];
                        ss += (hv[0] * hv[0] + hv[1] * hv[1]) + (hv[2] * hv[2] + hv[3] * hv[3]); }
                ss += __shfl_xor(ss, 16); ss += __shfl_xor(ss, 32);
                if (fq == 0) Pp[r * 4 + wc] = ss; }
        }
        asm volatile("s_waitcnt lgkmcnt(0)" ::: "memory"); __builtin_amdgcn_s_barrier(); asm volatile("" ::: "memory");
        const int tid = wid * 64 + lane;
        if (tid < 256) { const f32x4 p = *(const PG8_LAS f32x4*)(Pp + tid * 4);
            __hip_atomic_store(xbuf + (size_t)(u.pm * BM + tid) * 4 + u.pn, (p[0] + p[1]) + (p[2] + p[3]), __ATOMIC_RELAXED, __HIP_MEMORY_SCOPE_AGENT);
            asm volatile("s_waitcnt vmcnt(0)" ::: "memory");
            if (lane == 0) __hip_atomic_fetch_add(cnt + 64 * u.pm, 1u, __ATOMIC_RELAXED, __HIP_MEMORY_SCOPE_AGENT); }
        if (wid == 0) { unsigned spins = 0;
            while ((unsigned)__builtin_amdgcn_readfirstlane((int)__hip_atomic_load(cnt + 64 * u.pm, __ATOMIC_RELAXED, __HIP_MEMORY_SCOPE_AGENT)) < 16u) { __builtin_amdgcn_s_sleep(2); if (++spins > (1u << 22)) break; }
            __builtin_amdgcn_fence(__ATOMIC_ACQUIRE, "agent"); }
        asm volatile("s_waitcnt vmcnt(0) lgkmcnt(0)" ::: "memory"); __builtin_amdgcn_s_barrier(); asm volatile("" ::: "memory");
        if (tid < 256) { const float* slot = xbuf + (size_t)(u.pm * BM + tid) * 4; float q = 0.f;
#pragma unroll
            for (int t = 0; t < 4; ++t) q += __hip_atomic_load(slot + t, __ATOMIC_RELAXED, __HIP_MEMORY_SCOPE_AGENT);
            Sr[tid] = __frsqrt_rn(q * (1.0f / D) + EPS); }
        asm volatile("s_waitcnt lgkmcnt(0)" ::: "memory"); __builtin_amdgcn_s_barrier(); asm volatile("" ::: "memory");
        f32x4 wv[2][2];
#pragma unroll
        for (int bj = 0; bj < 2; ++bj)
#pragma unroll
            for (int n = 0; n < 2; ++n) wv[bj][n] = *(const f32x4*)(fw + col0 + bj * HALF + n * 16);
#pragma unroll
        for (int ai = 0; ai < 2; ++ai)
#pragma unroll
            for (int m = 0; m < 4; ++m) { const int r = ai * HALF + wr * 64 + m * 16 + fr; const size_t off = (size_t)(u.pm * BM + r) * D + col0; const float s = Sr[r];
#pragma unroll
                for (int bj = 0; bj < 2; ++bj)
#pragma unroll
                    for (int n = 0; n < 2; ++n) *(f32x4*)(hout + off + bj * HALF + n * 16) = acc[ai][bj][m][n] * s * wv[bj][n]; }
    }
};

template <class Epi, class Sched, bool ALIGN_EPI = false, bool SP2 = false, bool INIT = false>
__device__ __forceinline__ void gemm_phase(PG8_LAS unsigned char* lds, const Gemm g, const Sched& S, const Epi& E, f32x4 (&acc)[2][2][4][2]) {
    const int tid = threadIdx.x, wid = __builtin_amdgcn_readfirstlane(tid >> 6), lane = tid & 63, wr = wid >> 2, wc = wid & 3, fr = lane & 15, fq = lane >> 4;
    const int K = g.K, nt = K / BK;
    unsigned voffA[2], voffB[2];
#pragma unroll
    for (int i = 0; i < 2; ++i) { int R, C; stage_rc(tid * 16 + i * 8192, R, C); const int Rb = Epi::PERM ? ((R & ~31) + perm32(R & 31)) : R;
        voffA[i] = (unsigned)(R * K + C) * 2u; voffB[i] = (unsigned)(Rb * K + C) * 2u; }
    const size_t kstep = (size_t)(BK * 2);
    const size_t hstep = (size_t)HALF * K * 2;
    const size_t tstep = 2 * hstep;
    const unsigned ldsw = (unsigned)wid * 1024u;
    const int aoff = lds_byte(wr * 64 + fr, fq * 8), boff = lds_byte(wc * 32 + fr, fq * 8);
#define PG8_SA(b, h) (((b) * 2 + (h)) * HTB)
#define PG8_SB(b, h) ((4 + (b) * 2 + (h)) * HTB)
#define PG8_STAGE(bufoff, gbase, voff) do { _Pragma("unroll") for (int _i = 0; _i < 2; ++_i) \
        __builtin_amdgcn_global_load_lds((const unsigned*)((const char*)(gbase) + (voff)[_i]), (PG8_LAS unsigned*)(lds + (bufoff) + ldsw + _i * 8192), 16, 0, 0); } while (0)
#define PG8_LDA(dst, b, h) do { _Pragma("unroll") for (int m = 0; m < 4; ++m) _Pragma("unroll") for (int k = 0; k < 2; ++k) dst[m][k] = *(const PG8_LAS bf16x8*)(lds + PG8_SA(b, h) + aoff + m * 2048 + k * 1024); } while (0)
#define PG8_LDB(dst, b, h) do { _Pragma("unroll") for (int n = 0; n < 2; ++n) _Pragma("unroll") for (int k = 0; k < 2; ++k) dst[n][k] = *(const PG8_LAS bf16x8*)(lds + PG8_SB(b, h) + boff + n * 2048 + k * 1024); } while (0)
#define PG8_MMA(ai, bj, At, Bt) do { __builtin_amdgcn_s_setprio(1); _Pragma("unroll") for (int m = 0; m < 4; ++m) _Pragma("unroll") for (int n = 0; n < 2; ++n) _Pragma("unroll") for (int k = 0; k < 2; ++k) \
        acc[ai][bj][m][n] = __builtin_amdgcn_mfma_f32_16x16x32_bf16(Bt[n][k], At[m][k], acc[ai][bj][m][n], 0, 0, 0); __builtin_amdgcn_s_setprio(0); } while (0)
#define PG8_WAIT_V(n) asm volatile("s_waitcnt vmcnt(" #n ")" ::: "memory")
#define PG8_WAIT_L(n) asm volatile("s_waitcnt lgkmcnt(" #n ")" ::: "memory")
#define PG8_BAR __builtin_amdgcn_s_barrier()
#define PG8_SCHED __builtin_amdgcn_sched_barrier(0)
    Unit cur, nxt; int ui = 0;
    if (!S.next(0, cur)) return;
#pragma unroll
    for (int a = 0; a < 2; ++a)
#pragma unroll
        for (int b = 0; b < 2; ++b)
#pragma unroll
            for (int m = 0; m < 4; ++m)
#pragma unroll
                for (int n = 0; n < 2; ++n) { if constexpr (!INIT) acc[a][b][m][n] = (f32x4){0.f, 0.f, 0.f, 0.f}; }
    bf16x8 At[4][2], B0[2][2], B1[2][2];
    const char* cA = (const char*)g.A + (size_t)cur.pm * tstep; const char* cB = (const char*)g.Bt + (size_t)cur.pn * tstep;
    S.a_ready(cur);
    if constexpr (SP2) {
        PG8_STAGE(PG8_SB(0, 0), cB, voffB); PG8_STAGE(PG8_SB(0, 1), cB + hstep, voffB); PG8_STAGE(PG8_SA(0, 0), cA, voffA); PG8_STAGE(PG8_SA(0, 1), cA + hstep, voffA);
        if (wr == 1) PG8_BAR;
        PG8_WAIT_V(2); PG8_BAR;
        PG8_STAGE(PG8_SB(1, 0), cB + kstep, voffB); PG8_STAGE(PG8_SA(1, 0), cA + kstep, voffA); PG8_STAGE(PG8_SB(1, 1), cB + hstep + kstep, voffB);
        PG8_WAIT_V(6); PG8_BAR;
    } else {
        PG8_STAGE(PG8_SB(0, 0), cB, voffB); PG8_STAGE(PG8_SA(0, 0), cA, voffA); PG8_STAGE(PG8_SB(0, 1), cB + hstep, voffB); PG8_STAGE(PG8_SA(0, 1), cA + hstep, voffA);
        if (wr == 1) PG8_BAR;
        PG8_WAIT_V(4); PG8_BAR;
        PG8_STAGE(PG8_SB(1, 0), cB + kstep, voffB); PG8_STAGE(PG8_SA(1, 0), cA + kstep, voffA); PG8_STAGE(PG8_SB(1, 1), cB + hstep + kstep, voffB);
        PG8_WAIT_V(6); PG8_BAR;
    }
    for (;;) {
        const bool has_next = S.next(ui + 1, nxt);
        const char* nA = has_next ? (const char*)g.A + (size_t)nxt.pm * tstep : cA; const char* nB = has_next ? (const char*)g.Bt + (size_t)nxt.pn * tstep : cB;
        for (int t = 0; t < nt; t += 2) {
            const bool last = (t == nt - 2);
            const char* a1 = cA + (size_t)(t + 1) * kstep;
            const char* a2 = last ? nA : cA + (size_t)(t + 2) * kstep; const char* b2 = last ? nB : cB + (size_t)(t + 2) * kstep;
            const char* a3 = a2 + kstep; const char* b3 = b2 + kstep;
            if (last && has_next) S.a_ready(nxt);
            if constexpr (Epi::KHOOK) { if (t == Epi::KH0 || t == Epi::KH1) E.khook(acc, t, wr, fr, lds); }
            if constexpr (SP2) {
            PG8_LDB(B0, 0, 0); PG8_LDB(B1, 0, 1); PG8_SCHED; PG8_LDA(At, 0, 0); PG8_STAGE(PG8_SA(1, 1), a1 + hstep, voffA);
            PG8_WAIT_V(8); PG8_WAIT_L(0); PG8_BAR; PG8_MMA(0, 0, At, B0); PG8_MMA(0, 1, At, B1); PG8_BAR; PG8_SCHED;
            PG8_LDA(At, 0, 1); PG8_STAGE(PG8_SB(0, 0), b2, voffB); PG8_STAGE(PG8_SB(0, 1), b2 + hstep, voffB); PG8_STAGE(PG8_SA(0, 0), a2, voffA);
            PG8_WAIT_V(8); PG8_WAIT_L(0); PG8_BAR; PG8_MMA(1, 0, At, B0); PG8_MMA(1, 1, At, B1); PG8_BAR; PG8_SCHED;
            PG8_LDB(B0, 1, 0); PG8_LDB(B1, 1, 1); PG8_SCHED; PG8_LDA(At, 1, 0); PG8_STAGE(PG8_SA(0, 1), a2 + hstep, voffA);
            PG8_WAIT_V(8); PG8_WAIT_L(0); PG8_BAR; PG8_MMA(0, 0, At, B0); PG8_MMA(0, 1, At, B1); PG8_BAR; PG8_SCHED;
            PG8_LDA(At, 1, 1); PG8_STAGE(PG8_SB(1, 0), b3, voffB); PG8_STAGE(PG8_SB(1, 1), b3 + hstep, voffB); PG8_STAGE(PG8_SA(1, 0), a3, voffA);
            PG8_WAIT_V(8); PG8_WAIT_L(0); PG8_BAR; PG8_MMA(1, 0, At, B0); PG8_MMA(1, 1, At, B1); PG8_BAR; PG8_SCHED;
            } else {
            PG8_LDB(B0, 0, 0); PG8_SCHED; PG8_LDA(At, 0, 0); PG8_STAGE(PG8_SA(1, 1), a1 + hstep, voffA);
            PG8_WAIT_L(8); PG8_BAR; PG8_WAIT_L(0); PG8_MMA(0, 0, At, B0); PG8_BAR; PG8_SCHED;
            PG8_LDB(B1, 0, 1); PG8_STAGE(PG8_SB(0, 0), b2, voffB);
            PG8_BAR; PG8_WAIT_L(0); PG8_MMA(0, 1, At, B1); PG8_BAR;
            PG8_LDA(At, 0, 1); PG8_STAGE(PG8_SA(0, 0), a2, voffA);
            PG8_BAR; PG8_WAIT_L(0); PG8_MMA(1, 0, At, B0); PG8_BAR; PG8_SCHED;
            PG8_STAGE(PG8_SB(0, 1), b2 + hstep, voffB);
            PG8_WAIT_V(6); PG8_BAR; PG8_MMA(1, 1, At, B1); PG8_BAR;
            PG8_LDB(B0, 1, 0); PG8_SCHED; PG8_LDA(At, 1, 0); PG8_STAGE(PG8_SA(0, 1), a2 + hstep, voffA);
            PG8_WAIT_L(8); PG8_BAR; PG8_WAIT_L(0); PG8_MMA(0, 0, At, B0); PG8_BAR; PG8_SCHED;
            PG8_LDB(B1, 1, 1); PG8_STAGE(PG8_SB(1, 0), b3, voffB);
            PG8_BAR; PG8_WAIT_L(0); PG8_MMA(0, 1, At, B1); PG8_BAR;
            PG8_LDA(At, 1, 1); PG8_STAGE(PG8_SA(1, 0), a3, voffA);
            PG8_BAR; PG8_WAIT_L(0); PG8_MMA(1, 0, At, B0); PG8_BAR; PG8_SCHED;
            PG8_STAGE(PG8_SB(1, 1), b3 + hstep, voffB);
            PG8_WAIT_V(6); PG8_BAR; PG8_MMA(1, 1, At, B1); PG8_BAR;
            }
        }
        if constexpr (ALIGN_EPI) { if (wr == 0) PG8_BAR; }
        if constexpr (!Epi::AFTER_DRAIN) { E(acc, cur, wr, wc, fr, fq); S.done(cur); }
        if (!has_next) break;
#pragma unroll
        for (int a = 0; a < 2; ++a)
#pragma unroll
            for (int b = 0; b < 2; ++b)
#pragma unroll
                for (int m = 0; m < 4; ++m)
#pragma unroll
                    for (int n = 0; n < 2; ++n) acc[a][b][m][n] = (f32x4){0.f, 0.f, 0.f, 0.f};
        cur = nxt; cA = nA; cB = nB; ++ui;
        if constexpr (ALIGN_EPI) { if (wr == 1) PG8_BAR; }
    }
    PG8_WAIT_V(0);
    if constexpr (!ALIGN_EPI) { if (wr == 0) PG8_BAR; }
    PG8_BAR;
    if constexpr (Epi::AFTER_DRAIN) { E.fused(acc, cur, wr, wc, fr, fq, lds, wid, lane); S.done(cur); }
#undef PG8_SA
#undef PG8_SB
#undef PG8_STAGE
#undef PG8_LDA
#undef PG8_LDB
#undef PG8_MMA
#undef PG8_WAIT_V
#undef PG8_WAIT_L
#undef PG8_BAR
#undef PG8_SCHED
}
}
typedef unsigned short bf16_t;
typedef short bf16x8 __attribute__((ext_vector_type(8)));
typedef float f32x4 __attribute__((ext_vector_type(4)));
typedef unsigned u32x4 __attribute__((ext_vector_type(4)));
typedef unsigned u32x2 __attribute__((ext_vector_type(2)));
#define LAS __attribute__((address_space(3)))
#define LDS_WAIT() asm volatile("s_waitcnt lgkmcnt(0)" ::: "memory")

struct Params {
    const float *x, *meta, *norm1_w, *w_in, *ssd_conv_w, *ssd_conv_b, *ssd_dt_bias, *ssd_a_log, *ssd_d, *ssd_norm_w;
    const float *lru_conv_w, *lru_conv_b, *lru_wa, *lru_ba, *lru_wx, *lru_bx, *lru_lambda, *lru_norm_w;
    const float *w_out, *norm2_w, *w_gate, *w_up, *w_down, *final_norm_w;
    float* out; unsigned char* ws;
    int ph_lo, ph_hi;
};

__device__ __forceinline__ float bf2f(unsigned short b) { return __uint_as_float(((unsigned)b) << 16); }
__device__ __forceinline__ float bflo(unsigned w) { return __uint_as_float(w << 16); }
__device__ __forceinline__ float bfhi(unsigned w) { return __uint_as_float(w & 0xffff0000u); }
typedef float f32x2_t __attribute__((ext_vector_type(2))); typedef __bf16 bf16x2_t __attribute__((ext_vector_type(2)));
__device__ __forceinline__ unsigned pk2(float lo, float hi) { f32x2_t v = {lo, hi}; bf16x2_t b = __builtin_convertvector(v, bf16x2_t); return __builtin_bit_cast(unsigned, b); }
__device__ __forceinline__ unsigned short f2bf(float f) { return (unsigned short)(pk2(f, 0.f) & 0xffffu); }
__device__ __forceinline__ float sigm(float x) { return __builtin_amdgcn_rcpf(1.0f + __expf(-x)); }
__device__ __forceinline__ float siluf(float x) { return x * sigm(x); }
__device__ __forceinline__ float softplusf(float x) { return x > 20.f ? x : log1pf(__expf(x)); }
__device__ __forceinline__ float dpp_add(float v, const int ctrl_sel) {
    switch (ctrl_sel) {
        case 0: return v + __builtin_bit_cast(float, __builtin_amdgcn_update_dpp(0, __builtin_bit_cast(int, v), 0xB1, 0xF, 0xF, true));
        case 1: return v + __builtin_bit_cast(float, __builtin_amdgcn_update_dpp(0, __builtin_bit_cast(int, v), 0x4E, 0xF, 0xF, true));
        case 2: return v + __builtin_bit_cast(float, __builtin_amdgcn_update_dpp(0, __builtin_bit_cast(int, v), 0x141, 0xF, 0xF, true));
        default: return v + __builtin_bit_cast(float, __builtin_amdgcn_update_dpp(0, __builtin_bit_cast(int, v), 0x140, 0xF, 0xF, true));
    }
}
__device__ __forceinline__ float row16_sum(float v) { v = dpp_add(v, 0); v = dpp_add(v, 1); v = dpp_add(v, 2); v = dpp_add(v, 3); return v; }
__device__ __forceinline__ float wave_sum(float v) {
    v = row16_sum(v);
    const int iv = __builtin_bit_cast(int, v);
    return (__builtin_bit_cast(float, __builtin_amdgcn_readlane(iv, 0)) + __builtin_bit_cast(float, __builtin_amdgcn_readlane(iv, 16))) + (__builtin_bit_cast(float, __builtin_amdgcn_readlane(iv, 32)) + __builtin_bit_cast(float, __builtin_amdgcn_readlane(iv, 48)));
}
__device__ __forceinline__ int tok_row(int b, int t) { return t < NMETA ? MROWS + t : b * SEQ + (t - NMETA); }

template <bool SC> __device__ __forceinline__ void tr_item(const float* colp, bool valid, int Nsrc, const float* sck0, bf16_t* WT, int K, int n0, int k0, LAS float* scr, int lane) {
    const int hi = lane >> 5; float v[32];
#pragma unroll
    for (int i = 0; i < 32; ++i) v[i] = __builtin_nontemporal_load(colp + (size_t)(k0 + 2 * i + hi) * Nsrc);
    if (SC) {
#pragma unroll
        for (int i = 0; i < 32; ++i) v[i] *= sck0[2 * i + hi]; }
#pragma unroll
    for (int i = 0; i < 32; ++i) scr[(2 * i + hi) * 33 + (lane & 31)] = valid ? v[i] : 0.f;
    LDS_WAIT(); asm volatile("" ::: "memory");
    const int c = lane & 7;
#pragma unroll
    for (int j = 0; j < 4; ++j) { const int n = (lane >> 3) + 8 * j; const LAS float* s = scr + (8 * c) * 33 + n;
        u32x4 o; o.x = pk2(s[0 * 33], s[1 * 33]); o.y = pk2(s[2 * 33], s[3 * 33]); o.z = pk2(s[4 * 33], s[5 * 33]); o.w = pk2(s[6 * 33], s[7 * 33]);
        *(u32x4*)(WT + (size_t)(n0 + n) * K + k0 + 8 * c) = o; }
    LDS_WAIT(); asm volatile("" ::: "memory");
}
__device__ __forceinline__ void weight_items(const Params& P, unsigned char* lds, int part) {
    const int tid = threadIdx.x, lane = tid & 63, wave = tid >> 6;
    LAS float* scr = (LAS float*)((LAS unsigned char*)lds + wave * 16384);
    const int gw = blockIdx.x * 8 + wave, NGW = gridDim.x * 8;
    bf16_t* WinT = (bf16_t*)(P.ws + WS_WIN); bf16_t* WoutT = (bf16_t*)(P.ws + WS_WOUT); bf16_t* WguT = (bf16_t*)(P.ws + WS_WGU); bf16_t* WdT = (bf16_t*)(P.ws + WS_WD);
    constexpr int I_IN = 16 * (N1 / 32), I_OUT = 32 * 32, I_GU = 16 * (NGU / 32), I_D = (DFF / 64) * 32;
    const int ln = lane & 31;
    if (part == 0) {
        for (int r = gw; r < I_IN; r += NGW) { const int nnb = N1 / 32, kb = r / nnb, nb = r % nnb, n = 32 * nb + ln;
            int sc = -1; if (n < 2560) sc = n; else if (n < NPROJ) sc = n + 16; else if (n < NPROJ + 16) sc = 2560 + (n - NPROJ);
            tr_item<true>(P.w_in + (sc < 0 ? 0 : sc), sc >= 0, IN_COLS, P.norm1_w + 64 * kb, WinT, D, 32 * nb, 64 * kb, scr, lane); }
        return;
    }
    for (int it = gw; it < I_OUT + I_GU + I_D; it += NGW) {
        int r = it;
        if (r < I_OUT) { const int kb = r / 32, nb = r % 32, k0 = 64 * kb;
            tr_item<true>(P.w_out + 32 * nb + ln, true, D, k0 < 1024 ? P.ssd_norm_w + k0 : P.lru_norm_w + (k0 - 1024), WoutT, DMIX, 32 * nb, k0, scr, lane); continue; }
        r -= I_OUT;
        if (r < I_GU) { const int nnb = NGU / 32, kb = r / nnb, nb = r % nnb, n = 32 * nb + ln; const int pn = n >> 8, bj = (n >> 7) & 1, jj = n & 127;
            tr_item<true>((bj ? P.w_up : P.w_gate) + 128 * pn + jj, true, DFF, P.norm2_w + 64 * kb, WguT, D, 32 * nb, 64 * kb, scr, lane); continue; }
        r -= I_GU;
        { const int kb = r / 32, nb = r % 32; tr_item<false>(P.w_down + 32 * nb + ln, true, D, nullptr, WdT, DFF, 32 * nb, 64 * kb, scr, lane); }
    }
}
__device__ __forceinline__ void p0_prologue(const Params& P, unsigned char* lds) {
    const int tid = threadIdx.x, lane = tid & 63, wave = tid >> 6;
    const int gw = blockIdx.x * 8 + wave, NGW = gridDim.x * 8;
    weight_items(P, lds, 0);
    bf16_t* Xb = (bf16_t*)P.out; float* rstd1 = (float*)(P.ws + WS_RSTD1);
    for (int base = gw; base < M1; base += 3 * NGW) {
        f32x4 v[3][4];
#pragma unroll
        for (int u = 0; u < 3; ++u) { const int row = base + u * NGW;
            const int mr = row - MROWS; const float* src = row < MROWS ? P.x + (size_t)row * D : P.meta + (size_t)(mr < NMETA ? mr : NMETA - 1) * D; const bool zr = row >= MROWS + NMETA;
#pragma unroll
            for (int j = 0; j < 4; ++j) { const f32x4 ld = __builtin_nontemporal_load((const f32x4*)src + lane + 64 * j); v[u][j] = zr ? (f32x4){0.f, 0.f, 0.f, 0.f} : ld; } }
#pragma unroll
        for (int u = 0; u < 3; ++u) { const int row = base + u * NGW; if (row < M1) { float s = 0.f;
#pragma unroll
            for (int j = 0; j < 4; ++j) s += (v[u][j][0] * v[u][j][0] + v[u][j][1] * v[u][j][1]) + (v[u][j][2] * v[u][j][2] + v[u][j][3] * v[u][j][3]);
            s = wave_sum(s);
            if (lane == 0) rstd1[row] = __frsqrt_rn(s * (1.0f / D) + EPS);
            u32x2* o8 = (u32x2*)(Xb + (size_t)row * D) + lane;
#pragma unroll
            for (int j = 0; j < 4; ++j) { u32x2 w; w.x = pk2(v[u][j][0], v[u][j][1]); w.y = pk2(v[u][j][2], v[u][j][3]); o8[64 * j] = w; } } }
    }
}

constexpr int PITCH = 272;
#define MFMA16(a, b, c) __builtin_amdgcn_mfma_f32_16x16x32_bf16((a), (b), (c), 0, 0, 0)
constexpr size_t IMG_G = 98304, IMG_XS_BASE = (size_t)BATCH * 17 * 2 * IMG_G, IMG_SC_BASE = IMG_XS_BASE + (size_t)BATCH * 17 * 16 * 16384, IMG_END = IMG_SC_BASE + (size_t)BATCH * 17 * 16 * 1536;
static_assert(IMG_END <= (size_t)MROWS * D * 4, "SSD images fit in d_out");
constexpr size_t WS_SUMA = 247 * MiB, WS_SUMH = 248 * MiB, WS_BAR = 249 * MiB;

#define CVT8(dst, src) do { dst[0] = bflo(src.x); dst[1] = bfhi(src.x); dst[2] = bflo(src.y); dst[3] = bfhi(src.y); dst[4] = bflo(src.z); dst[5] = bfhi(src.z); dst[6] = bflo(src.w); dst[7] = bfhi(src.w); } while (0)

__device__ __forceinline__ void ssd_prep_item(const Params& P, unsigned char* ldsg, int b, int c, int kind) {
    LAS unsigned char* T = (LAS unsigned char*)ldsg;
    const int tid = threadIdx.x, lane = tid & 63, w = __builtin_amdgcn_readfirstlane(tid >> 6);
    const int t0 = c == 0 ? -112 : NMETA + 128 * (c - 1);
    unsigned char* IMG = (unsigned char*)P.out;
    const bf16_t* proj = (const bf16_t*)(P.ws + WS_PROJ);
    const int bc = b * 17 + c;
    if (kind < 4) {
        const int g = kind & 1, isC = kind >> 1, oct = tid & 15, l0 = 4 * (tid >> 4);
        const int cch = 1024 + isC * 256 + g * 128 + oct * 8;
        u32x4 rw[7];
#pragma unroll
        for (int i = 0; i < 7; ++i) { const int t = t0 + l0 - 3 + i; const u32x4 ld = *(const u32x4*)(proj + (size_t)tok_row(b, t < 0 ? 0 : t) * NPROJ + COL_XBC + cch); rw[i] = t >= 0 ? ld : (u32x4){0u, 0u, 0u, 0u}; }
        float cw[4][8], cb[8];
#pragma unroll
        for (int k = 0; k < 4; ++k) { const f32x4 a0 = *(const f32x4*)(P.ssd_conv_w + k * 1536 + cch), a1 = *(const f32x4*)(P.ssd_conv_w + k * 1536 + cch + 4);
#pragma unroll
            for (int j = 0; j < 4; ++j) { cw[k][j] = a0[j]; cw[k][4 + j] = a1[j]; } }
        { const f32x4 b0 = *(const f32x4*)(P.ssd_conv_b + cch), b1 = *(const f32x4*)(P.ssd_conv_b + cch + 4);
#pragma unroll
          for (int j = 0; j < 4; ++j) { cb[j] = b0[j]; cb[4 + j] = b1[j]; } }
        float y[4][8];
#pragma unroll
        for (int k = 0; k < 4; ++k)
#pragma unroll
            for (int j = 0; j < 8; ++j) y[k][j] = cb[j];
#pragma unroll
        for (int i = 0; i < 7; ++i) { float xv[8]; CVT8(xv, rw[i]);
#pragma unroll
            for (int k = 0; k < 4; ++k) { const int tap = i - k; if (tap >= 0 && tap < 4) {
#pragma unroll
                for (int j = 0; j < 8; ++j) y[k][j] += cw[tap][j] * xv[j]; } } }
        unsigned char* img = IMG + ((size_t)bc * 2 + g) * IMG_G + (isC ? 65536 : 0);
#pragma unroll
        for (int k = 0; k < 4; ++k) { const bool valid = (t0 + l0 + k) >= 0;
#pragma unroll
            for (int j = 0; j < 8; ++j) y[k][j] = valid ? siluf(y[k][j]) : 0.f;
            u32x4 o; o.x = pk2(y[k][0], y[k][1]); o.y = pk2(y[k][2], y[k][3]); o.z = pk2(y[k][4], y[k][5]); o.w = pk2(y[k][6], y[k][7]);
            *(u32x4*)(img + ((l0 + k) * 128 + oct * 8) * 2) = o; }
        if (!isC) {
#pragma unroll
            for (int j = 0; j < 8; ++j) { u32x2 o; o.x = pk2(y[0][j], y[1][j]); o.y = pk2(y[2][j], y[3][j]); *(LAS u32x2*)(T + (oct * 8 + j) * PITCH + l0 * 2) = o; }
            __syncthreads();
#pragma unroll
            for (int k = 0; k < 4; ++k) { const int piece = tid + 512 * k, n = piece >> 4, k16 = piece & 15; const u32x4 v = *(const LAS u32x4*)(T + n * PITCH + k16 * 16);
                *(u32x4*)(img + 32768 + n * 256 + k16 * 16) = v; }
            __syncthreads();
        }
    } else {
        const int g = (kind - 4) >> 1, hh = (kind - 4) & 1, h0 = 8 * g + 4 * hh;
        if (w < 4) {
            const int h = h0 + w; const float Aneg = -__expf(P.ssd_a_log[h]), dtb = P.ssd_dt_bias[h]; const float* dtraw = (const float*)(P.ws + WS_DTRAW);
            float d0 = 0.f, d1 = 0.f; const int ta = t0 + 2 * lane, tb = ta + 1;
            { const float r0 = dtraw[(size_t)tok_row(b, ta < 0 ? 0 : ta) * 16 + h], r1 = dtraw[(size_t)tok_row(b, tb < 0 ? 0 : tb) * 16 + h];
              d0 = ta >= 0 ? softplusf(r0 + dtb) : 0.f; d1 = tb >= 0 ? softplusf(r1 + dtb) : 0.f; }
            const float v0 = d0 * Aneg, v1 = d1 * Aneg, s = v0 + v1; float inc = s;
#pragma unroll
            for (int o = 1; o < 64; o <<= 1) { const float nb = __shfl_up(inc, o); if (lane >= o) inc += nb; }
            const float exc = inc - s, cs0 = exc + v0, cs1 = inc, csEnd = __shfl(inc, 63);
            float* sc = (float*)(IMG + IMG_SC_BASE + ((size_t)bc * 16 + h) * 1536);
            typedef float f32x2 __attribute__((ext_vector_type(2)));
            *(f32x2*)(sc + 2 * lane) = (f32x2){d0, d1}; *(f32x2*)(sc + 128 + 2 * lane) = (f32x2){cs0, cs1}; *(f32x2*)(sc + 256 + 2 * lane) = (f32x2){d0 * __expf(csEnd - cs0), d1 * __expf(csEnd - cs1)};
        }
        const int oct = tid & 31, l0 = 8 * (tid >> 5), cch = h0 * 64 + oct * 8;
        u32x4 rw[11];
#pragma unroll
        for (int i = 0; i < 11; ++i) { const int t = t0 + l0 - 3 + i; const u32x4 ld = *(const u32x4*)(proj + (size_t)tok_row(b, t < 0 ? 0 : t) * NPROJ + COL_XBC + cch); rw[i] = t >= 0 ? ld : (u32x4){0u, 0u, 0u, 0u}; }
        float cw[4][8], cb[8];
#pragma unroll
        for (int k = 0; k < 4; ++k) { const f32x4 a0 = *(const f32x4*)(P.ssd_conv_w + k * 1536 + cch), a1 = *(const f32x4*)(P.ssd_conv_w + k * 1536 + cch + 4);
#pragma unroll
            for (int j = 0; j < 4; ++j) { cw[k][j] = a0[j]; cw[k][4 + j] = a1[j]; } }
        { const f32x4 b0 = *(const f32x4*)(P.ssd_conv_b + cch), b1 = *(const f32x4*)(P.ssd_conv_b + cch + 4);
#pragma unroll
          for (int j = 0; j < 4; ++j) { cb[j] = b0[j]; cb[4 + j] = b1[j]; } }
#pragma unroll
        for (int hf = 0; hf < 2; ++hf) {
            float y[4][8];
#pragma unroll
            for (int k = 0; k < 4; ++k)
#pragma unroll
                for (int j = 0; j < 8; ++j) y[k][j] = cb[j];
#pragma unroll
            for (int i = 0; i < 7; ++i) { float xv[8]; CVT8(xv, rw[4 * hf + i]);
#pragma unroll
                for (int k = 0; k < 4; ++k) { const int tap = i - k; if (tap >= 0 && tap < 4) {
#pragma unroll
                    for (int j = 0; j < 8; ++j) y[k][j] += cw[tap][j] * xv[j]; } } }
#pragma unroll
            for (int k = 0; k < 4; ++k) { const bool valid = (t0 + l0 + 4 * hf + k) >= 0;
#pragma unroll
                for (int j = 0; j < 8; ++j) y[k][j] = valid ? siluf(y[k][j]) : 0.f; }
#pragma unroll
            for (int j = 0; j < 8; ++j) { u32x2 o; o.x = pk2(y[0][j], y[1][j]); o.y = pk2(y[2][j], y[3][j]); *(LAS u32x2*)(T + (oct * 8 + j) * PITCH + (l0 + 4 * hf) * 2) = o; }
        }
        __syncthreads();
        unsigned char* ximg = IMG + IMG_XS_BASE + ((size_t)bc * 16 + h0) * 16384;
#pragma unroll
        for (int k = 0; k < 8; ++k) { const int piece = tid + 512 * k, row = piece >> 4, k16 = piece & 15; const u32x4 v = *(const LAS u32x4*)(T + row * PITCH + k16 * 16);
            *(u32x4*)(ximg + row * 256 + k16 * 16) = v; }
        __syncthreads();
    }
}

__device__ __forceinline__ void ssd_item(const Params& P, unsigned char* ldsg, int b, int h) {
    LAS unsigned char* lds = (LAS unsigned char*)ldsg;
    const int tid = threadIdx.x, lane = tid & 63, w = __builtin_amdgcn_readfirstlane(tid >> 6), r = lane & 15, q = lane >> 4;
    const int g = h >> 3;
    LAS unsigned char* sB = lds; LAS unsigned char* sBT = lds + 34816; LAS unsigned char* sC = lds + 69632; LAS unsigned char* sX = lds + 104448; LAS unsigned char* sP = lds + 121856;
    LAS float* sDt = (LAS float*)(lds + 139264); LAS float* sCs = sDt + 128; LAS float* sF = sDt + 256;
    const bf16_t* proj = (const bf16_t*)(P.ws + WS_PROJ);
    bf16_t* mix = (bf16_t*)(P.ws + WS_MIX); float* ssqs = (float*)(P.ws + WS_SSQS);
    const unsigned char* IMG = (const unsigned char*)P.out;
    const float Dh = P.ssd_d[h];
    f32x4 acch[4];
#pragma unroll
    for (int i = 0; i < 4; ++i) acch[i] = (f32x4){0.f, 0.f, 0.f, 0.f};
    u32x4 pf[14], pfs;
#define SSD_ISSUE(cc) do { const int bc_ = b * 17 + (cc); const unsigned char* gimg_ = IMG + ((size_t)bc_ * 2 + g) * IMG_G; const unsigned char* ximg_ = IMG + IMG_XS_BASE + ((size_t)bc_ * 16 + h) * 16384; \
        _Pragma("unroll") for (int k_ = 0; k_ < 12; ++k_) pf[k_] = *(const u32x4*)(gimg_ + (size_t)(tid + 512 * k_) * 16); \
        _Pragma("unroll") for (int k_ = 0; k_ < 2; ++k_) pf[12 + k_] = *(const u32x4*)(ximg_ + (size_t)(tid + 512 * k_) * 16); \
        if (tid < 96) pfs = *(const u32x4*)(IMG + IMG_SC_BASE + ((size_t)bc_ * 16 + h) * 1536 + tid * 16); } while (0)
    SSD_ISSUE(0);
    for (int c = 0; c < 17; ++c) {
#pragma unroll
        for (int k = 0; k < 12; ++k) { const int pc = (tid + 512 * k) & 2047; *(LAS u32x4*)(lds + (k >> 2) * 34816 + (pc >> 4) * PITCH + (pc & 15) * 16) = pf[k]; }
#pragma unroll
        for (int k = 0; k < 2; ++k) { const int pc = tid + 512 * k; *(LAS u32x4*)(sX + (pc >> 4) * PITCH + (pc & 15) * 16) = pf[12 + k]; }
        if (tid < 96) *(LAS u32x4*)((LAS unsigned char*)sDt + tid * 16) = pfs;
        __syncthreads();
        u32x2 zr[4];
        const int lt = w < 4 ? w : 11 - w;
        if (c > 0) { const size_t mrow_ = (size_t)b * SEQ + 128 * (c - 1) + 16 * lt + r;
#pragma unroll
            for (int rt = 0; rt < 4; ++rt) zr[rt] = *(const u32x2*)(proj + mrow_ * NPROJ + COL_Z + h * 64 + 16 * rt + 4 * q); }
        if (c < 16) SSD_ISSUE(c + 1);
        if (c > 0) {
            const int l = 16 * lt + r; const float cs_l = sCs[l];
            const size_t mrow = (size_t)b * SEQ + 128 * (c - 1) + l;
            bf16x8 cf[4];
#pragma unroll
            for (int ks = 0; ks < 4; ++ks) cf[ks] = *(const LAS bf16x8*)(sC + l * PITCH + ks * 64 + q * 16);
            f32x4 accy[4];
#pragma unroll
            for (int rt = 0; rt < 4; ++rt) accy[rt] = (f32x4){0.f, 0.f, 0.f, 0.f};
#pragma unroll
            for (int rt = 0; rt < 4; ++rt)
#pragma unroll
                for (int ks = 0; ks < 4; ++ks) { const bf16x8 a = *(const LAS bf16x8*)(sP + (16 * rt + r) * PITCH + ks * 64 + q * 16); accy[rt] = MFMA16(a, cf[ks], accy[rt]); }
            { const float e = __expf(cs_l);
#pragma unroll
              for (int rt = 0; rt < 4; ++rt) accy[rt] *= e; }
            const int stmax = (lt | 1);
            for (int st = 0; st <= stmax; ++st) {
                f32x4 a4 = (f32x4){0.f, 0.f, 0.f, 0.f};
                if (st <= lt) {
#pragma unroll
                    for (int ks = 0; ks < 4; ++ks) { const bf16x8 a = *(const LAS bf16x8*)(sB + (16 * st + r) * PITCH + ks * 64 + q * 16); a4 = MFMA16(a, cf[ks], a4); }
                }
                float mv[4]; const f32x4 csv = *(const LAS f32x4*)(sCs + 16 * st + 4 * q), dtv = *(const LAS f32x4*)(sDt + 16 * st + 4 * q);
#pragma unroll
                for (int j = 0; j < 4; ++j) { const int s = 16 * st + 4 * q + j; mv[j] = (s <= l) ? a4[j] * __expf(cs_l - csv[j]) * dtv[j] : 0.f; }
                u32x2 o; o.x = pk2(mv[0], mv[1]); o.y = pk2(mv[2], mv[3]);
                *(LAS u32x2*)(sC + l * PITCH + (16 * st + 4 * q) * 2) = o;
            }
            LDS_WAIT();
            for (int ks = 0; ks <= (lt >> 1); ++ks) { const bf16x8 mb = *(const LAS bf16x8*)(sC + l * PITCH + ks * 64 + q * 16);
#pragma unroll
                for (int rt = 0; rt < 4; ++rt) { const bf16x8 a = *(const LAS bf16x8*)(sX + (16 * rt + r) * PITCH + ks * 64 + q * 16); accy[rt] = MFMA16(a, mb, accy[rt]); } }
            { float ss = 0.f;
#pragma unroll
              for (int rt = 0; rt < 4; ++rt) { const int p0 = 16 * rt + 4 * q;
                  const float z[4] = {bflo(zr[rt].x), bfhi(zr[rt].x), bflo(zr[rt].y), bfhi(zr[rt].y)}; float gv[4];
#pragma unroll
                  for (int j = 0; j < 4; ++j) { const float xs = bf2f(*(const LAS unsigned short*)(sX + (p0 + j) * PITCH + l * 2)); const float yv = accy[rt][j] + Dh * xs; gv[j] = yv * z[j]; ss += gv[j] * gv[j]; }
                  u32x2 o; o.x = pk2(gv[0], gv[1]); o.y = pk2(gv[2], gv[3]); *(u32x2*)(mix + mrow * DMIX + h * 64 + p0) = o; }
              ss += __shfl_xor(ss, 16); ss += __shfl_xor(ss, 32);
              if (q == 0) ssqs[mrow * 16 + h] = ss; }
        }
        if (c < 16) {
            const float cd = __expf(sCs[127]);
#pragma unroll
            for (int ct = 0; ct < 4; ++ct) acch[ct] *= cd;
#pragma unroll
            for (int ks = 0; ks < 4; ++ks) { const u32x4 ar = *(const LAS u32x4*)(sBT + (16 * w + r) * PITCH + ks * 64 + q * 16);
                const f32x4 f0 = *(const LAS f32x4*)(sF + ks * 32 + q * 8), f1 = *(const LAS f32x4*)(sF + ks * 32 + q * 8 + 4);
                u32x4 o; o.x = pk2(bflo(ar.x) * f0[0], bfhi(ar.x) * f0[1]); o.y = pk2(bflo(ar.y) * f0[2], bfhi(ar.y) * f0[3]); o.z = pk2(bflo(ar.z) * f1[0], bfhi(ar.z) * f1[1]); o.w = pk2(bflo(ar.w) * f1[2], bfhi(ar.w) * f1[3]);
                const bf16x8 a = __builtin_bit_cast(bf16x8, o);
#pragma unroll
                for (int ct = 0; ct < 4; ++ct) { const bf16x8 bx = *(const LAS bf16x8*)(sX + (16 * ct + r) * PITCH + ks * 64 + q * 16); acch[ct] = MFMA16(a, bx, acch[ct]); } }
        }
        __syncthreads();
        if (c < 16) {
#pragma unroll
            for (int ct = 0; ct < 4; ++ct) { u32x2 o; o.x = pk2(acch[ct][0], acch[ct][1]); o.y = pk2(acch[ct][2], acch[ct][3]); *(LAS u32x2*)(sP + (16 * ct + r) * PITCH + (16 * w + 4 * q) * 2) = o; }
        }
    }
#undef SSD_ISSUE
    __syncthreads();
}

__device__ __forceinline__ float one_minus_exp(float t) {
    const float big = 1.0f - __expf(t);
    const float small = -t * (1.0f + t * (0.5f + t * (0.16666667f + t * (0.041666668f + t * 0.008333334f))));
    return t > -0.25f ? small : big;
}
__device__ __forceinline__ void lru_item(const Params& P, unsigned char* ldsg, int b, int n) {
    LAS unsigned char* lds = (LAS unsigned char*)ldsg;
    const int tid = threadIdx.x, lane = tid & 63, w = __builtin_amdgcn_readfirstlane(tid >> 6), r = lane & 15, q = lane >> 4;
    constexpr int FP = 68, XBP = 144;
    LAS float* sXr = (LAS float*)lds; LAS float* sA = (LAS float*)(lds + 34816); LAS float* sM = (LAS float*)(lds + 69632);
    LAS unsigned char* sXb = lds + 104448; LAS float* sSegA = (LAS float*)(lds + 122880); LAS float* sSegH = sSegA + 512; LAS float* sCarry = sSegH + 512;
    const bf16_t* proj = (const bf16_t*)(P.ws + WS_PROJ); bf16_t* mix = (bf16_t*)(P.ws + WS_MIX); float* ssql = (float*)(P.ws + WS_SSQL);
    const int which = w >> 2, ct = w & 3, cg_ = 16 * ct + r, chan = 64 * n + cg_;
    bf16x8 bfrag[2];
    { const float* Wsrc = (which ? P.lru_wx : P.lru_wa) + (size_t)n * 4096;
#pragma unroll
      for (int ks = 0; ks < 2; ++ks) { float v[8];
#pragma unroll
          for (int j = 0; j < 8; ++j) v[j] = Wsrc[(ks * 32 + q * 8 + j) * 64 + cg_];
          u32x4 o; o.x = pk2(v[0], v[1]); o.y = pk2(v[2], v[3]); o.z = pk2(v[4], v[5]); o.w = pk2(v[6], v[7]); bfrag[ks] = __builtin_bit_cast(bf16x8, o); } }
    const float gb2 = -1.4426950408889634f * (which ? P.lru_bx[chan] : P.lru_ba[chan]);
    const float spl8 = -8.0f * 1.4426950408889634f * log1pf(__expf(-P.lru_lambda[chan]));
    const int so = tid & 7, lq = tid >> 3, sch = 64 * n + 8 * so;
    float cw[4][8], cb[8];
#pragma unroll
    for (int k = 0; k < 4; ++k) { const f32x4 a0 = *(const f32x4*)(P.lru_conv_w + k * 1024 + sch), a1 = *(const f32x4*)(P.lru_conv_w + k * 1024 + sch + 4);
#pragma unroll
        for (int j = 0; j < 4; ++j) { cw[k][j] = a0[j]; cw[k][4 + j] = a1[j]; } }
    { const f32x4 b0 = *(const f32x4*)(P.lru_conv_b + sch), b1 = *(const f32x4*)(P.lru_conv_b + sch + 4);
#pragma unroll
      for (int j = 0; j < 4; ++j) { cb[j] = b0[j]; cb[4 + j] = b1[j]; } }
    if (tid < 64) sCarry[tid] = 0.f;
    u32x4 raw[2][4];
#define LRU_ISSUE(cc) do { const int t0_ = (cc) == 0 ? -112 : NMETA + 128 * ((cc) - 1); \
        _Pragma("unroll") for (int hh_ = 0; hh_ < 2; ++hh_) _Pragma("unroll") for (int k_ = 0; k_ < 4; ++k_) { const int tk_ = t0_ + lq + 64 * hh_ - 3 + k_; \
            const u32x4 ld_ = *(const u32x4*)(proj + (size_t)tok_row(b, tk_ < 0 ? 0 : tk_) * NPROJ + COL_XLRU + sch); raw[hh_][k_] = tk_ >= 0 ? ld_ : (u32x4){0u, 0u, 0u, 0u}; } } while (0)
    LRU_ISSUE(0);
    for (int c = 0; c < 17; ++c) {
        const int t0 = c == 0 ? -112 : NMETA + 128 * (c - 1);
        const int lb = 16 * w;
        unsigned short gt[16];
        if (c > 0) {
#pragma unroll
            for (int i = 0; i < 16; ++i) gt[i] = proj[((size_t)b * SEQ + 128 * (c - 1) + lb + i) * NPROJ + COL_GATE + 64 * n + lane];
        }
#pragma unroll
        for (int hh = 0; hh < 2; ++hh) {
            const int l = lq + 64 * hh, t = t0 + l; float y[8];
#pragma unroll
            for (int j = 0; j < 8; ++j) y[j] = cb[j];
#pragma unroll
            for (int k = 0; k < 4; ++k) { float xv[8]; CVT8(xv, raw[hh][k]);
#pragma unroll
                for (int j = 0; j < 8; ++j) y[j] += cw[k][j] * xv[j]; }
            if (t < 0) {
#pragma unroll
                for (int j = 0; j < 8; ++j) y[j] = 0.f; }
            *(LAS f32x4*)(sXr + l * FP + 8 * so) = (f32x4){y[0], y[1], y[2], y[3]}; *(LAS f32x4*)(sXr + l * FP + 8 * so + 4) = (f32x4){y[4], y[5], y[6], y[7]};
            u32x4 o; o.x = pk2(y[0], y[1]); o.y = pk2(y[2], y[3]); o.z = pk2(y[4], y[5]); o.w = pk2(y[6], y[7]);
            *(LAS u32x4*)(sXb + l * XBP + so * 16) = o;
        }
        if (c < 16) LRU_ISSUE(c + 1);
        __syncthreads();
        if (which == 0) {
#pragma unroll 2
            for (int rt = 0; rt < 8; ++rt) {
                f32x4 a4 = (f32x4){0.f, 0.f, 0.f, 0.f};
#pragma unroll
                for (int ks = 0; ks < 2; ++ks) { const bf16x8 a = *(const LAS bf16x8*)(sXb + (16 * rt + r) * XBP + ks * 64 + q * 16); a4 = MFMA16(a, bfrag[ks], a4); }
#pragma unroll
                for (int j = 0; j < 4; ++j) { const int l = 16 * rt + 4 * q + j; const float gte = __builtin_amdgcn_rcpf(1.0f + __builtin_amdgcn_exp2f(__builtin_fmaf(a4[j], -1.4426950408889634f, gb2)));
                    const float av = __builtin_amdgcn_exp2f(gte * spl8);
                    sA[l * FP + cg_] = av; sM[l * FP + cg_] = __builtin_amdgcn_sqrtf(__builtin_fmaxf(__builtin_fmaf(-av, av, 1.0f), 0.f)); }
            }
            if (c == 0) {
#pragma unroll
                for (int rt = 0; rt < 7; ++rt)
#pragma unroll
                    for (int j = 0; j < 4; ++j) sA[(16 * rt + 4 * q + j) * FP + cg_] = 1.0f; }
        } else {
#pragma unroll 2
            for (int rt = 0; rt < 8; ++rt) {
                float xr4[4];
#pragma unroll
                for (int j = 0; j < 4; ++j) xr4[j] = sXr[(16 * rt + 4 * q + j) * FP + cg_];
                f32x4 a4 = (f32x4){0.f, 0.f, 0.f, 0.f};
#pragma unroll
                for (int ks = 0; ks < 2; ++ks) { const bf16x8 a = *(const LAS bf16x8*)(sXb + (16 * rt + r) * XBP + ks * 64 + q * 16); a4 = MFMA16(a, bfrag[ks], a4); }
#pragma unroll
                for (int j = 0; j < 4; ++j) { const float gte = __builtin_amdgcn_rcpf(1.0f + __builtin_amdgcn_exp2f(__builtin_fmaf(a4[j], -1.4426950408889634f, gb2)));
                    sXr[(16 * rt + 4 * q + j) * FP + cg_] = gte * xr4[j]; }
            }
        }
        __syncthreads();
        { float av[16], uv[16];
#pragma unroll
          for (int i = 0; i < 16; ++i) { const int o = (lb + i) * FP + lane; av[i] = sA[o]; uv[i] = sM[o] * sXr[o]; }
          float hl = 0.f, ap = 1.f;
#pragma unroll
          for (int i = 0; i < 16; ++i) { const int o = (lb + i) * FP + lane; hl = av[i] * hl + uv[i]; ap *= av[i]; sXr[o] = hl; sM[o] = ap; }
          sSegA[w * 64 + lane] = ap; sSegH[w * 64 + lane] = hl; }
        __syncthreads();
        float carry = sCarry[lane];
        for (int s = 0; s < w; ++s) carry = sSegA[s * 64 + lane] * carry + sSegH[s * 64 + lane];
        float hend = 0.f;
#pragma unroll
        for (int i = 0; i < 16; ++i) { const int o = (lb + i) * FP + lane; const float hv = sXr[o] + sM[o] * carry; hend = hv;
            if (c > 0) { const size_t mrow = (size_t)b * SEQ + 128 * (c - 1) + lb + i; const float yv = bf2f(gt[i]) * hv;
                mix[mrow * DMIX + 1024 + 64 * n + lane] = f2bf(yv); sA[o] = yv * yv; } }
        __syncthreads();
        if (w == 7) sCarry[lane] = hend;
        if (c > 0) { const int row = tid >> 2, part = tid & 3; const LAS f32x4* pq = (const LAS f32x4*)(sA + row * FP + part * 16);
            const f32x4 s0 = pq[0], s1 = pq[1], s2 = pq[2], s3 = pq[3];
            float ss = (((s0[0] + s0[1]) + (s0[2] + s0[3])) + ((s1[0] + s1[1]) + (s1[2] + s1[3]))) + (((s2[0] + s2[1]) + (s2[2] + s2[3])) + ((s3[0] + s3[1]) + (s3[2] + s3[3])));
            ss = dpp_add(ss, 0); ss = dpp_add(ss, 1);
            if (part == 0) ssql[((size_t)b * SEQ + 128 * (c - 1) + row) * 16 + n] = ss; }
    }
#undef LRU_ISSUE
    __syncthreads();
}
#define XB_TMO      128
#define XB_XCNT(j)  (256  + 64 * (j))
#define XB_XSUB(j)  (1280 + 64 * (j))
#define XB_XGEN(j)  (2304 + 64 * (j))
#define XB_TOP      3328
#define XB_TOPGEN   3392
#define XCD_BAR_WORDS 3456
#define XB_SPIN_CAP (1u << 18)
__device__ __forceinline__ unsigned xb_ld(unsigned* p)              { return __hip_atomic_load(p, __ATOMIC_RELAXED, __HIP_MEMORY_SCOPE_AGENT); }
__device__ __forceinline__ unsigned xb_add(unsigned* p, unsigned v) { return __hip_atomic_fetch_add(p, v, __ATOMIC_RELAXED, __HIP_MEMORY_SCOPE_AGENT); }
__device__ __forceinline__ unsigned xb_xcc_id() { return (unsigned)__builtin_amdgcn_s_getreg((3 << 11) | 20) & 0xFu; }
#define XB_SPIN(cond, bar) do { unsigned _sp = 0; while (cond) { __builtin_amdgcn_s_sleep(1); \
    if ((++_sp & 255u) == 0u) { if (xb_ld(&(bar)[XB_TMO])) break; if (_sp > XB_SPIN_CAP) { atomicAdd(&(bar)[XB_TMO], 1u); break; } } } } while (0)
struct XcdBarrier { unsigned* bar; unsigned x; volatile LAS unsigned* st; };
__device__ __forceinline__ XcdBarrier xcd_barrier_post(unsigned* bar, volatile LAS unsigned* st) {
    XcdBarrier b; b.bar = bar; b.x = xb_xcc_id(); b.st = st;
    if (threadIdx.x == 0) (void)xb_add(&bar[XB_XCNT(b.x)], 1u);
    return b;
}
__device__ __forceinline__ void xcd_barrier_complete(unsigned* bar, unsigned x, unsigned& nloc, unsigned& nx) {
    const unsigned G = gridDim.x * gridDim.y * gridDim.z;
    unsigned sum, cnt, mine, sp = 0u;
    for (;;) {
        sum = 0u; cnt = 0u; mine = 0u;
#pragma unroll
        for (unsigned j = 0; j < 16; ++j) { const unsigned c = xb_ld(&bar[XB_XCNT(j)]); sum += c; cnt += (c > 0u) ? 1u : 0u; mine = (j == x) ? c : mine; }
        if (sum == G) break;
        __builtin_amdgcn_s_sleep(1);
        if ((++sp & 255u) == 0u) { if (xb_ld(&bar[XB_TMO])) break; if (sp > XB_SPIN_CAP) { atomicAdd(&bar[XB_TMO], 1u); break; } }
    }
    nloc = mine > 0u ? mine : 1u; nx = cnt > 0u ? cnt : 1u;
}
__device__ __forceinline__ void xcd_barrier(const XcdBarrier& b) {
    asm volatile("s_waitcnt vmcnt(0)" ::: "memory");
    __syncthreads();
    if (threadIdx.x == 0) {
        unsigned* bar = b.bar;
        __builtin_amdgcn_s_waitcnt(0);
        unsigned nloc = b.st[0], nx = b.st[1];
        if (nloc == 0u) { xcd_barrier_complete(bar, b.x, nloc, nx); b.st[0] = nloc; b.st[1] = nx; }
        const unsigned old = xb_add(&bar[XB_XSUB(b.x)], 1u);
        const unsigned gen = old / nloc;
        if (old + 1u == (gen + 1u) * nloc) {
            __builtin_amdgcn_fence(__ATOMIC_RELEASE, "agent");
            asm volatile("s_waitcnt vmcnt(0)" ::: "memory");
            const unsigned og = xb_add(&bar[XB_TOP], 1u);
            const unsigned tg = og / nx;
            if (og + 1u == (tg + 1u) * nx) xb_add(&bar[XB_TOPGEN], 1u);
            else XB_SPIN(xb_ld(&bar[XB_TOPGEN]) == tg, bar);
            __builtin_amdgcn_fence(__ATOMIC_ACQUIRE, "agent");
            xb_add(&bar[XB_XGEN(b.x)], 1u);
            asm volatile("s_waitcnt vmcnt(0)" ::: "memory");
        } else {
            XB_SPIN(xb_ld(&bar[XB_XGEN(b.x)]) == gen, bar);
            __builtin_amdgcn_fence(__ATOMIC_ACQUIRE, "agent");
            asm volatile("s_waitcnt vmcnt(0)" ::: "memory");
        }
    }
    __syncthreads();
}

#ifndef PH_MASK
#define PH_MASK 255
#endif
#ifndef REP1
#define REP1 1
#define REP2 1
#define REP3 1
#define REP4 1
#define REP5 1
#endif
constexpr int NPHASE = 7;
constexpr size_t WS_CNT = WS_BAR + 16384;
__global__ void __launch_bounds__(NTHREADS, 2) hymba_fwd(Params P) {
    extern __shared__ __attribute__((aligned(16))) unsigned char lds[];
    cg::grid_group grid = cg::this_grid();
    const int lo = P.ph_lo, hi = P.ph_hi, G = gridDim.x, blk = blockIdx.x;
    volatile LAS unsigned* MISC = (volatile LAS unsigned*)((LAS unsigned char*)lds + (LDS_BYTES - 64));
    if (threadIdx.x < 2) MISC[threadIdx.x] = 0u;
    __syncthreads();
    const XcdBarrier bar = xcd_barrier_post((unsigned*)(P.ws + WS_BAR), MISC);
    if (hi > 1000) grid.sync();
#define IN(k) (((PH_MASK >> (k)) & 1) && lo <= (k) && (k) < hi)
#define SEAM(k) do { if (lo <= (k) && (k) + 1 < hi) xcd_barrier(bar); } while (0)
    PG8_LAS unsigned char* ldsp = (PG8_LAS unsigned char*)lds;
    bf16_t* proj = (bf16_t*)(P.ws + WS_PROJ);
    if (IN(0)) { p0_prologue(P, lds); __syncthreads(); }
    SEAM(0);
    if (IN(1)) for (int rep = 0; rep < REP1; ++rep) {
        pg8::Gemm g{(const bf16_t*)P.out, (const bf16_t*)(P.ws + WS_WIN), M1, N1, D}; pg8::StaticOrder S; S.init(M1, N1, G, blk, WGM_P1);
        pg8::EpiProj E{proj, (float*)(P.ws + WS_DTRAW), (const float*)(P.ws + WS_RSTD1)};
        f32x4 accz[2][2][4][2]; pg8::gemm_phase<pg8::EpiProj, pg8::StaticOrder, true, true>(ldsp, g, S, E, accz);
        __syncthreads();
    }
    SEAM(1);
    if (IN(2)) for (int rep = 0; rep < REP2; ++rep) {
        weight_items(P, lds, 1); __syncthreads();
        if (G == 256) {
            constexpr int NBC = BATCH * 17, NX = 4 * NBC;
            for (int k = 0; k < 6; ++k) { int kind = -1, bc = 0;
                if (k < 3) { const int xi = blk + 256 * k; if (k < 2 || blk < 32) { if (xi < NX) { kind = 4 + xi / NBC; bc = xi % NBC; } } }
                else { int bi = -1; const int j = blk - 32, kk = k - 3;
                    if (blk < 32) { if (kk == 0) bi = blk; } else if (kk < 2) bi = 32 + 224 * kk + j; else if (j < 64) bi = 32 + 448 + j;
                    if (bi >= 0 && bi < NX) { kind = bi / NBC; bc = bi % NBC; } }
                if (kind >= 0) ssd_prep_item(P, lds, bc / 17, bc % 17, kind); }
        } else
        for (int it = blk; it < BATCH * 17 * 8; it += G) { const int bc = it % (BATCH * 17); ssd_prep_item(P, lds, bc / 17, bc % 17, it / (BATCH * 17)); }
    }
    SEAM(2);
    if (IN(3)) for (int rep = 0; rep < REP3; ++rep) {
        for (int v = blk; v < 256; v += G) if (((v >> 3) & 1) == 0) { const int xcd = v & 7, slot = v >> 4; ssd_item(P, lds, (xcd >> 1) | ((slot >> 3) << 2), 8 * (xcd & 1) + (slot & 7)); }
        for (int v = blk; v < 256; v += G) if (((v >> 3) & 1) == 1) { const int idx = ((v >> 4) << 3) | (v & 7); lru_item(P, lds, idx >> 4, idx & 15); }
    }
    f32x4 accI[2][2][4][2], accJ[2][2][4][2];
#define PRELOAD_TILE(accI, src, Ncols) do { pg8::StaticOrder S_; S_.init(MROWS, (Ncols), G, blk); pg8::Unit u_; if (S_.next(0, u_)) { \
        const int wid_ = threadIdx.x >> 6, lane_ = threadIdx.x & 63, wr_ = wid_ >> 2, wc_ = wid_ & 3, fr_ = lane_ & 15, fq_ = lane_ >> 4; \
        _Pragma("unroll") for (int ai = 0; ai < 2; ++ai) _Pragma("unroll") for (int bj = 0; bj < 2; ++bj) _Pragma("unroll") for (int m = 0; m < 4; ++m) _Pragma("unroll") for (int n = 0; n < 2; ++n) \
            accI[ai][bj][m][n] = *(const f32x4*)((src) + (size_t)(u_.pm * 256 + ai * 128 + wr_ * 64 + m * 16 + fr_) * D + u_.pn * 256 + bj * 128 + wc_ * 32 + n * 16 + 4 * fq_); } } while (0)
    if (IN(4)) PRELOAD_TILE(accI, P.x, D);
    SEAM(3);
    if (IN(4)) {
        pg8::Gemm g{(const bf16_t*)(P.ws + WS_MIX), (const bf16_t*)(P.ws + WS_WOUT), MROWS, D, DMIX}; pg8::StaticOrder S; S.init(MROWS, D, G, blk);
        pg8::Unit u0;
        if (S.next(0, u0) && threadIdx.x < 256) {
            const int row = u0.pm * 256 + threadIdx.x; const f32x4* a = (const f32x4*)((const float*)(P.ws + WS_SSQS) + (size_t)row * 16); const f32x4* l4 = (const f32x4*)((const float*)(P.ws + WS_SSQL) + (size_t)row * 16);
            const f32x4 a0 = a[0], a1 = a[1], a2 = a[2], a3 = a[3], l0 = l4[0], l1 = l4[1], l2 = l4[2], l3 = l4[3];
            const float g0 = ((a0[0] + a0[1]) + (a0[2] + a0[3])) + ((a1[0] + a1[1]) + (a1[2] + a1[3])), g1 = ((a2[0] + a2[1]) + (a2[2] + a2[3])) + ((a3[0] + a3[1]) + (a3[2] + a3[3]));
            const float ls = (((l0[0] + l0[1]) + (l0[2] + l0[3])) + ((l1[0] + l1[1]) + (l1[2] + l1[3]))) + (((l2[0] + l2[1]) + (l2[2] + l2[3])) + ((l3[0] + l3[1]) + (l3[2] + l3[3])));
            const float r0 = __frsqrt_rn(g0 * (1.0f / 512.f) + EPS), r1 = __frsqrt_rn(g1 * (1.0f / 512.f) + EPS), rl = __frsqrt_rn(ls * (1.0f / 1024.f) + EPS);
            *(PG8_LAS f32x4*)(ldsp + pg8::STAGE_BYTES + threadIdx.x * 16) = (f32x4){r0 / r1, r1 / rl, rl, __builtin_amdgcn_rcpf(r0)};
        }
        __syncthreads();
        { const int wid_ = threadIdx.x >> 6, lane_ = threadIdx.x & 63, wr_ = wid_ >> 2, fr_ = lane_ & 15;
#pragma unroll
          for (int ai = 0; ai < 2; ++ai)
#pragma unroll
              for (int m = 0; m < 4; ++m) { const float iv = (*(const PG8_LAS f32x4*)(ldsp + pg8::STAGE_BYTES + (ai * 128 + wr_ * 64 + m * 16 + fr_) * 16))[3];
#pragma unroll
                  for (int bj = 0; bj < 2; ++bj)
#pragma unroll
                      for (int n = 0; n < 2; ++n) accI[ai][bj][m][n] *= iv; } }
        pg8::EpiOut E{(bf16_t*)(P.ws + WS_H1B), (float*)(P.ws + WS_SSQ2)};
        pg8::gemm_phase<pg8::EpiOut, pg8::StaticOrder, false, true, true>(ldsp, g, S, E, accI);
        __syncthreads();
    }
    SEAM(4);
    if (IN(5)) for (int rep = 0; rep < REP5; ++rep) {
        pg8::Gemm g{(const bf16_t*)(P.ws + WS_H1B), (const bf16_t*)(P.ws + WS_WGU), MROWS, NGU, D}; pg8::StaticOrder S; S.init(MROWS, NGU, G, blk, WGM_P4);
        pg8::EpiGU E{(bf16_t*)(P.ws + WS_ACT), (const float*)(P.ws + WS_SSQ2)};
        f32x4 accz[2][2][4][2]; pg8::gemm_phase<pg8::EpiGU, pg8::StaticOrder, true, true>(ldsp, g, S, E, accz);
        __syncthreads();
    }
    if (IN(6)) { pg8::StaticOrder S_; S_.init(MROWS, D, G, blk); pg8::Unit u_; if (S_.next(0, u_)) {
        const int wid_ = threadIdx.x >> 6, lane_ = threadIdx.x & 63, wr_ = wid_ >> 2, wc_ = wid_ & 3, fr_ = lane_ & 15, fq_ = lane_ >> 4; const bf16_t* h1b_ = (const bf16_t*)(P.ws + WS_H1B);
#pragma unroll
        for (int ai = 0; ai < 2; ++ai)
#pragma unroll
            for (int bj = 0; bj < 2; ++bj)
#pragma unroll
                for (int m = 0; m < 4; ++m)
#pragma unroll
                    for (int n = 0; n < 2; ++n) { const u32x2 rv = *(const u32x2*)(h1b_ + (size_t)(u_.pm * 256 + ai * 128 + wr_ * 64 + m * 16 + fr_) * D + u_.pn * 256 + bj * 128 + wc_ * 32 + n * 16 + 4 * fq_);
                        accJ[ai][bj][m][n] = (f32x4){bflo(rv.x), bfhi(rv.x), bflo(rv.y), bfhi(rv.y)}; } } }
    SEAM(5);
    if (IN(6)) {
        pg8::Gemm g{(const bf16_t*)(P.ws + WS_ACT), (const bf16_t*)(P.ws + WS_WD), MROWS, D, DFF}; pg8::StaticOrder S; S.init(MROWS, D, G, blk);
        pg8::EpiDownNorm E{P.out, P.final_norm_w, (float*)(P.ws + WS_SSQ3), (unsigned*)(P.ws + WS_CNT)};
        pg8::gemm_phase<pg8::EpiDownNorm, pg8::StaticOrder, false, true, true>(ldsp, g, S, E, accJ);
        __syncthreads();
    }
#undef IN
#undef SEAM
}

extern "C" void kernel_launch(void* const* d_in, const int* in_sizes, int n_in, void* d_out, int out_size, void* d_ws, size_t ws_size, hipStream_t stream) {
    static int grid = 0;
    if (grid == 0) {
        if (n_in != 24 || out_size != MROWS * D || ws_size < WS_BAR + 32768) { fprintf(stderr, "kernel_launch: unexpected problem shape (n_in %d, out %d, ws %zu)\n", n_in, out_size, ws_size); grid = -1; return; }
        int dev = 0, cus = 0, per_cu = 0;
        if (hipGetDevice(&dev) != hipSuccess || hipDeviceGetAttribute(&cus, hipDeviceAttributeMultiprocessorCount, dev) != hipSuccess) { grid = -1; return; }
        if (hipFuncSetAttribute((const void*)hymba_fwd, hipFuncAttributeMaxDynamicSharedMemorySize, LDS_BYTES) != hipSuccess) { fprintf(stderr, "kernel_launch: hipFuncSetAttribute failed\n"); grid = -1; return; }
        if (hipOccupancyMaxActiveBlocksPerMultiprocessor(&per_cu, (const void*)hymba_fwd, NTHREADS, LDS_BYTES) != hipSuccess || per_cu < 1) { fprintf(stderr, "kernel_launch: occupancy query says %d blocks per CU\n", per_cu); (void)hipGetLastError(); }
        grid = cus;
        if (grid != 256) fprintf(stderr, "kernel_launch: %d CUs; the one-unit-per-workgroup GEMM phases assume 256\n", grid);
    }
    if (grid < 0) return;
    Params p{};
    const float** pp = (const float**)&p;
    for (int i = 0; i < 24; ++i) pp[i] = (const float*)d_in[i];
    p.out = (float*)d_out; p.ws = (unsigned char*)d_ws;
    (void)hipMemsetAsync((unsigned char*)d_ws + WS_BAR, 0, 32768, stream);
#if MK_LAUNCHES == 1
    p.ph_lo = 0; p.ph_hi = NPHASE;
    void* args[] = {&p};
    hipError_t e = hipLaunchCooperativeKernel((void*)hymba_fwd, dim3(grid), dim3(NTHREADS), args, LDS_BYTES, stream);
    if (e != hipSuccess) fprintf(stderr, "kernel_launch: cooperative launch failed: %s\n", hipGetErrorString(e));
#else
    for (int ph = 0; ph < NPHASE; ++ph) { p.ph_lo = ph; p.ph_hi = ph + 1; hipLaunchKernelGGL(hymba_fwd, dim3(grid), dim3(NTHREADS), LDS_BYTES, stream, p); }
#endif
}
```
